# Optimizing an MI355X kernel written in HIP

```python
import math
import jax, jax.numpy as jnp
from jax import lax
import numpy as np

D_MODEL = 1024
BATCH = 2
SEQ = 8192
DEPTH = 4

N_A_LAYERS = DEPTH // 2
N_B_LAYERS = DEPTH - N_A_LAYERS
RET_HEADS = 4
RET_QK_DIM = D_MODEL // RET_HEADS
RET_V_DIM = 2 * D_MODEL // RET_HEADS
RET_CHUNK = 128
ROPE_BASE = 10000.0
SWA_HEADS = 16
SWA_KV_HEADS = 4
SWA_GROUP = SWA_HEADS // SWA_KV_HEADS
SWA_HEAD_DIM = 64
WINDOW = 128
BLOCK = WINDOW
REL_BUCKETS = 32
REL_MAX_DIST = 128
D_FF = 2816
CONV_WIDTH = 3
NORM_EPS = 1e-6

kernel_name = "yoco_retention_swa_sink_hybrid"


def rmsnorm(x, g):
    x32 = x.astype(jnp.float32)
    y = x32 * lax.rsqrt(jnp.mean(x32 * x32, axis=-1, keepdims=True) + NORM_EPS)
    return (y * g.astype(jnp.float32)).astype(x.dtype)


def adaln_in(x, g, shift, scale):
    return rmsnorm(x, g) * (1 + scale[:, None, :]) + shift[:, None, :]


def rotary(x, pos):
    d = x.shape[-1]
    half = d // 2
    inv = ROPE_BASE ** (-jnp.arange(half, dtype=jnp.float32) / half)
    ang = pos.astype(jnp.float32)[:, None] * inv[None, :]
    cos = jnp.cos(ang)[None, :, None, :]
    sin = jnp.sin(ang)[None, :, None, :]
    x32 = x.astype(jnp.float32)
    x1, x2 = x32[..., :half], x32[..., half:]
    return jnp.concatenate([x1 * cos - x2 * sin, x2 * cos + x1 * sin], axis=-1)


def retention(h, w_in, w_out):
    B, S, _ = h.shape
    H, dk, dv, C = RET_HEADS, RET_QK_DIM, RET_V_DIM, RET_CHUNK
    NC = S // C
    proj = h @ w_in
    q, k, v, g = jnp.split(proj, [H * dk, 2 * H * dk, 2 * H * dk + H * dv], axis=-1)
    pos = jnp.arange(S)
    q = rotary(q.reshape(B, S, H, dk), pos)
    k = rotary(k.reshape(B, S, H, dk), pos) * (dk ** -0.5)
    v = v.reshape(B, S, H, dv).astype(jnp.float32)

    def to_chunks(t):
        return t.reshape(B, NC, C, H, t.shape[-1]).transpose(1, 0, 3, 2, 4)

    log_gamma = jnp.log(1.0 - 2.0 ** (-5.0 - jnp.arange(H, dtype=jnp.float32)))
    idx = jnp.arange(C, dtype=jnp.float32)
    diff = idx[:, None] - idx[None, :]
    dmask = jnp.where(diff[None] >= 0, jnp.exp(jnp.maximum(diff, 0.0)[None] * log_gamma[:, None, None]), 0.0)
    xi = jnp.exp((idx[None, :] + 1.0) * log_gamma[:, None])
    zeta = jnp.exp((C - 1.0 - idx[None, :]) * log_gamma[:, None])
    g_chunk = jnp.exp(C * log_gamma)

    def step(R, qkv):
        qc, kc, vc = qkv
        s = jnp.einsum('bhqd,bhkd->bhqk', qc, kc) * dmask[None]
        inner = jnp.einsum('bhqk,bhkv->bhqv', s, vc)
        cross = jnp.einsum('bhqd,bhdv->bhqv', qc, R) * xi[None, :, :, None]
        R_new = R * g_chunk[None, :, None, None] + jnp.einsum('bhkd,bhkv->bhdv', kc, vc * zeta[None, :, :, None])
        return R_new, inner + cross

    R0 = jnp.zeros((B, H, dk, dv), jnp.float32)
    _, o = lax.scan(step, R0, (to_chunks(q), to_chunks(k), to_chunks(v)))
    o = o.transpose(1, 0, 3, 2, 4).reshape(B, S, H, dv)
    mu = jnp.mean(o, axis=-1, keepdims=True)
    var = jnp.mean(jnp.square(o - mu), axis=-1, keepdims=True)
    o = ((o - mu) * lax.rsqrt(var + NORM_EPS)).reshape(B, S, H * dv).astype(h.dtype)
    return (jax.nn.silu(g) * o) @ w_out


def shared_kv(x, g, shift, scale, w_kv):
    B, S, _ = x.shape
    NB = S // BLOCK
    h = adaln_in(x, g, shift, scale)
    k, v = jnp.split(h @ w_kv, 2, axis=-1)

    def band(t):
        t = t.reshape(B, S, SWA_KV_HEADS, SWA_HEAD_DIM)
        t = jnp.pad(t, ((0, 0), (BLOCK, 0), (0, 0), (0, 0)))
        tb = t.reshape(B, NB + 1, BLOCK, SWA_KV_HEADS, SWA_HEAD_DIM)
        return jnp.concatenate([tb[:, :-1], tb[:, 1:]], axis=2)

    return band(k), band(v)


def rel_bias_band(table):
    i = jnp.arange(BLOCK)[:, None]
    j = jnp.arange(2 * BLOCK)[None, :]
    dist = i + BLOCK - j
    n = jnp.maximum(dist, 0)
    max_exact = REL_BUCKETS // 2
    large = max_exact + (jnp.log(jnp.maximum(n, 1).astype(jnp.float32) / max_exact)
                         / math.log(REL_MAX_DIST / max_exact) * (REL_BUCKETS - max_exact)).astype(jnp.int32)
    large = jnp.minimum(large, REL_BUCKETS - 1)
    bucket = jnp.where(n < max_exact, n, large)
    bias = table[bucket].astype(jnp.float32)
    bias = bias.transpose(2, 0, 1).reshape(SWA_KV_HEADS, SWA_GROUP, BLOCK, 2 * BLOCK)
    win = (dist >= 0) & (dist < WINDOW)
    return bias, win


def swa_sink_attention(h, w_q, w_o, sinks, k_band, v_band, bias, mask):
    B, S, _ = h.shape
    NB = S // BLOCK
    q = (h @ w_q).reshape(B, NB, BLOCK, SWA_KV_HEADS, SWA_GROUP, SWA_HEAD_DIM)
    s = jnp.einsum('bnqhgd,bnkhd->bnhgqk', q, k_band).astype(jnp.float32) * (SWA_HEAD_DIM ** -0.5)
    s = s + bias[None, None]
    s = jnp.where(mask[None, :, None, None], s, -jnp.inf)
    sink = sinks.astype(jnp.float32).reshape(SWA_KV_HEADS, SWA_GROUP)[None, None, :, :, None, None]
    m = jnp.maximum(jnp.max(s, axis=-1, keepdims=True), sink)
    e = jnp.exp(s - m)
    p = e / (jnp.sum(e, axis=-1, keepdims=True) + jnp.exp(sink - m))
    o = jnp.einsum('bnhgqk,bnkhd->bnqhgd', p.astype(v_band.dtype), v_band)
    return o.reshape(B, S, SWA_HEADS * SWA_HEAD_DIM) @ w_o


def conv_ffn(h, w_up, conv_w, conv_b, w_down):
    S = h.shape[1]
    u = h @ w_up
    u_pad = jnp.pad(u, ((0, 0), (CONV_WIDTH - 1, 0), (0, 0)))
    uc = conv_b + sum(conv_w[j] * u_pad[:, j:j + S] for j in range(CONV_WIDTH))
    gate, val = jnp.split(uc, 2, axis=-1)
    return (jax.nn.silu(gate) * val) @ w_down


def setup_inputs(seed: int = 0) -> dict:
    key = jax.random.key(seed)
    ks = jax.random.split(key, 24)
    D, F = D_MODEL, D_FF
    nrm = lambda k, shape, s: jax.random.normal(k, shape, jnp.float32) * s
    ret_in_cols = 2 * RET_HEADS * RET_QK_DIM + 2 * RET_HEADS * RET_V_DIM
    return {
        "x": nrm(ks[0], (BATCH, SEQ, D), 1.0),
        "c": nrm(ks[1], (BATCH, D), 1.0),
        "norm_g": 1.0 + nrm(ks[2], (DEPTH, 4, D), 0.05),
        "ada_w": nrm(ks[3], (DEPTH, D, 6 * D), 0.1 * D ** -0.5),
        "ada_b": nrm(ks[4], (DEPTH, 6 * D), 0.01),
        "ret_w_in": nrm(ks[5], (N_A_LAYERS, D, ret_in_cols), D ** -0.5),
        "ret_w_out": nrm(ks[6], (N_A_LAYERS, RET_HEADS * RET_V_DIM, D), (RET_HEADS * RET_V_DIM) ** -0.5),
        "kv_norm_g": 1.0 + nrm(ks[7], (D,), 0.05),
        "kv_ada_w": nrm(ks[8], (D, 2 * D), 0.1 * D ** -0.5),
        "kv_ada_b": nrm(ks[9], (2 * D,), 0.01),
        "kv_w": nrm(ks[10], (D, 2 * SWA_KV_HEADS * SWA_HEAD_DIM), D ** -0.5),
        "swa_w_q": nrm(ks[11], (N_B_LAYERS, D, SWA_HEADS * SWA_HEAD_DIM), D ** -0.5),
        "swa_w_o": nrm(ks[12], (N_B_LAYERS, SWA_HEADS * SWA_HEAD_DIM, D), (SWA_HEADS * SWA_HEAD_DIM) ** -0.5),
        "swa_sinks": nrm(ks[13], (N_B_LAYERS, SWA_HEADS), 0.5),
        "rel_bias": nrm(ks[14], (REL_BUCKETS, SWA_HEADS), 0.5),
        "ffn_w_up": nrm(ks[15], (DEPTH, D, 2 * F), D ** -0.5),
        "ffn_conv_w": nrm(ks[16], (DEPTH, CONV_WIDTH, 2 * F), CONV_WIDTH ** -0.5),
        "ffn_conv_b": nrm(ks[17], (DEPTH, 2 * F), 0.01),
        "ffn_w_down": nrm(ks[18], (DEPTH, F, D), F ** -0.5),
    }


def reference(x, c, norm_g, ada_w, ada_b, ret_w_in, ret_w_out, kv_norm_g, kv_ada_w, kv_ada_b, kv_w,
              swa_w_q, swa_w_o, swa_sinks, rel_bias, ffn_w_up, ffn_conv_w, ffn_conv_b, ffn_w_down):
    S = x.shape[1]
    NB = S // BLOCK
    c_act = jax.nn.silu(c)
    bias, win = rel_bias_band(rel_bias)
    kpos = jnp.arange(NB)[:, None] * BLOCK - BLOCK + jnp.arange(2 * BLOCK)[None, :]
    mask = win[None] & (kpos >= 0)[:, None, :]
    k_band = None
    v_band = None
    for l in range(DEPTH):
        mod = c_act @ ada_w[l] + ada_b[l]
        sh_m, sc_m, gt_m, sh_f, sc_f, gt_f = jnp.split(mod, 6, axis=-1)
        h = adaln_in(x, norm_g[l, 0], sh_m, sc_m)
        if l < N_A_LAYERS:
            y = retention(h, ret_w_in[l], ret_w_out[l])
        else:
            i = l - N_A_LAYERS
            y = swa_sink_attention(h, swa_w_q[i], swa_w_o[i], swa_sinks[i], k_band, v_band, bias, mask)
        x = x + (1 + gt_m)[:, None, :] * rmsnorm(y, norm_g[l, 1])
        h = adaln_in(x, norm_g[l, 2], sh_f, sc_f)
        y = conv_ffn(h, ffn_w_up[l], ffn_conv_w[l], ffn_conv_b[l], ffn_w_down[l])
        x = x + (1 + gt_f)[:, None, :] * rmsnorm(y, norm_g[l, 3])
        if l == N_A_LAYERS - 1:
            kv_mod = c_act @ kv_ada_w + kv_ada_b
            kv_shift, kv_scale = jnp.split(kv_mod, 2, axis=-1)
            k_band, v_band = shared_kv(x, kv_norm_g, kv_shift, kv_scale, kv_w)
    return x
```

```cpp
#include <hip/hip_runtime.h>
#include <cstdio>
#include <cstdint>

#ifndef MK_N_LAUNCHES
#define MK_N_LAUNCHES 0
#endif
#ifndef NAIVE_P1
#define NAIVE_P1 1
#endif
#ifndef NAIVE_P2
#define NAIVE_P2 1
#endif
#ifndef NAIVE_ATT
#define NAIVE_ATT 1
#endif

constexpr int BATCH = 2, SEQ = 8192, D = 1024, M = BATCH * SEQ, DEPTH = 4;
constexpr int RH = 4, RDK = 256, RDV = 512, RC = 128, NCH = SEQ / RC;
constexpr int RETN = 6144, FF = 2816, FF2 = 5632;
constexpr int SHEADS = 16, SKVH = 4, SHD = 64, WIN = 128;
constexpr float NORM_EPS = 1e-6f;

namespace pg8 {
#define PG8_LAS __attribute__((address_space(3)))
typedef unsigned short bf16_t;
typedef short bf16x8 __attribute__((ext_vector_type(8)));
typedef float f32x4 __attribute__((ext_vector_type(4)));
typedef unsigned u32x4 __attribute__((ext_vector_type(4)));
constexpr int BM = 256, BK = 64, HALF = 128, HTB = HALF * BK * 2  , STAGE_BYTES = 8 * HTB, NXCD = 8, WGM = 8;

__host__ __device__ __forceinline__ int lds_byte(int r, int c) { const int st = (r >> 4) * 2 + (c >> 5), rr = r & 15, cc = c & 31, ob = rr * 64 + cc * 2; return st * 1024 + (ob ^ (((ob >> 9) & 1) << 5)); }
__host__ __device__ __forceinline__ void stage_rc(int b, int& R, int& C) { const int st = b / 1024, sb = b % 1024, swz = sb ^ (((sb >> 9) & 1) << 5); R = (st >> 1) * 16 + swz / 64; C = (st & 1) * 32 + (swz % 64) / 2; }
__host__ __device__ __forceinline__ int perm32(int rho) { const int n = rho >> 4, i = rho & 15; return 8 * (i >> 2) + 4 * n + (i & 3); }

struct Unit { int pm, pn; };
struct Gemm { const bf16_t* A; const bf16_t* Bt; int M, N, K; };

struct StaticOrder {
    int nM, nN, nwg, G, c;
    __host__ __device__ void init(int M, int N, int G_, int c_) { nM = M / BM; nN = N / BM; nwg = nM * nN; G = G_; c = c_; }
    __host__ __device__ bool next(int i, Unit& u) const {
        const long L = (long)i * G + c; if (L >= nwg) return false;
        int wgid = (int)L; { const int q = nwg / NXCD, r = nwg % NXCD, xcd = wgid % NXCD, off = wgid / NXCD; wgid = (xcd < r ? xcd * (q + 1) : r * (q + 1) + (xcd - r) * q) + off; }
        const int nig = WGM * nN, gid = wgid / nig, fm = gid * WGM, gsz = (nM - fm) < WGM ? (nM - fm) : WGM;
        u.pm = fm + ((wgid % nig) % gsz); u.pn = (wgid % nig) / gsz; return true;
    }
    __device__ __forceinline__ void a_ready(const Unit&) const {}
    __device__ __forceinline__ void done(const Unit&) const {}
};
__device__ __forceinline__ unsigned cvt_pk_bf16(float lo, float hi) { unsigned r; asm volatile("v_cvt_pk_bf16_f32 %0, %1, %2" : "=v"(r) : "v"(lo), "v"(hi)); return r; }
typedef float f32x2 __attribute__((ext_vector_type(2)));
__device__ __forceinline__ float silu_f(float x) { return x * __builtin_amdgcn_rcpf(1.0f + __expf(-x)); }
__device__ __forceinline__ u32x4 pack8(const f32x4 v0, const f32x4 v1) { u32x4 w; w.x = cvt_pk_bf16(v0[0], v0[1]); w.y = cvt_pk_bf16(v0[2], v0[3]); w.z = cvt_pk_bf16(v1[0], v1[1]); w.w = cvt_pk_bf16(v1[2], v1[3]); return w; }

struct EpiBf16S {
    static constexpr bool PERM = true, AFTER_DRAIN = false;
    bf16_t* O; int ldc; int split_cols; size_t split_stride; float scale;
    __device__ __forceinline__ void operator()(const f32x4 (&acc)[2][2][4][2], const Unit& u, int wr, int wc, int fr, int fq) const {
        const int row0 = u.pm * BM + wr * 64 + fr; int colt = u.pn * BM; bf16_t* base = O;
        if (split_cols) { const int t = colt / split_cols; base += (size_t)t * split_stride; colt -= t * split_cols; }
        const int col0 = colt + wc * 32 + 8 * fq;
#pragma unroll
        for (int ai = 0; ai < 2; ++ai)
#pragma unroll
            for (int m = 0; m < 4; ++m) { bf16_t* rowp = base + (size_t)(row0 + ai * HALF + m * 16) * ldc + col0;
#pragma unroll
                for (int bj = 0; bj < 2; ++bj) *(u32x4*)(rowp + bj * HALF) = pack8(acc[ai][bj][m][0] * scale, acc[ai][bj][m][1] * scale); }
    }
};

struct EpiRetQKG {
    static constexpr bool PERM = true, AFTER_DRAIN = false;
    bf16_t* QT; bf16_t* KT; bf16_t* G; const float* cosT; const float* sinT; const float* scq; const float* sck;
    __device__ __forceinline__ void operator()(const f32x4 (&acc)[2][2][4][2], const Unit& u, int wr, int wc, int fr, int fq) const {
        const int row0 = u.pm * BM + wr * 64 + fr;
        if (u.pn < 8) {
            const int head = u.pn & 3; const bool isk = u.pn >= 4;
            bf16_t* dst = (isk ? KT : QT) + head * 256;
            const float* sct = (isk ? sck : scq) + head * 128;
            const int ci = wc * 32 + 8 * fq;
#pragma unroll
            for (int ai = 0; ai < 2; ++ai)
#pragma unroll
                for (int m = 0; m < 4; ++m) {
                    const int row = row0 + ai * HALF + m * 16, pos = row & (SEQ - 1);
                    const float s = sct[pos & 127];
                    const f32x4 c0 = *(const f32x4*)(cosT + (size_t)pos * 128 + ci), c1 = *(const f32x4*)(cosT + (size_t)pos * 128 + ci + 4);
                    const f32x4 s0 = *(const f32x4*)(sinT + (size_t)pos * 128 + ci), s1 = *(const f32x4*)(sinT + (size_t)pos * 128 + ci + 4);
                    const f32x4 a0 = acc[ai][0][m][0], a1 = acc[ai][0][m][1], b0 = acc[ai][1][m][0], b1 = acc[ai][1][m][1];
                    const f32x4 o10 = (a0 * c0 - b0 * s0) * s, o11 = (a1 * c1 - b1 * s1) * s, o20 = (b0 * c0 + a0 * s0) * s, o21 = (b1 * c1 + a1 * s1) * s;
                    bf16_t* rowp = dst + (size_t)row * 1024 + ci;
                    *(u32x4*)(rowp) = pack8(o10, o11); *(u32x4*)(rowp + 128) = pack8(o20, o21);
                }
        } else {
            const int col0 = (u.pn - 8) * BM + wc * 32 + 8 * fq;
#pragma unroll
            for (int ai = 0; ai < 2; ++ai)
#pragma unroll
                for (int m = 0; m < 4; ++m) { bf16_t* rowp = G + (size_t)(row0 + ai * HALF + m * 16) * 2048 + col0;
#pragma unroll
                    for (int bj = 0; bj < 2; ++bj) { f32x4 v0 = acc[ai][bj][m][0], v1 = acc[ai][bj][m][1];
#pragma unroll
                        for (int e = 0; e < 4; ++e) { v0[e] = silu_f(v0[e]); v1[e] = silu_f(v1[e]); }
                        *(u32x4*)(rowp + bj * HALF) = pack8(v0, v1); } }
        }
    }
};

struct EpiVT {
    static constexpr bool PERM = true, AFTER_DRAIN = false;
    bf16_t* VT;
    __device__ __forceinline__ void operator()(const f32x4 (&acc)[2][2][4][2], const Unit& u, int wr, int wc, int fr, int fq) const {
        const int ch0 = u.pm * BM + wr * 64 + fr, tok0 = u.pn * BM + wc * 32 + 8 * fq;
#pragma unroll
        for (int ai = 0; ai < 2; ++ai)
#pragma unroll
            for (int m = 0; m < 4; ++m) { const int ch = ch0 + ai * HALF + m * 16, h = ch >> 9, dv = ch & 511;
#pragma unroll
                for (int bj = 0; bj < 2; ++bj) { const int tok = tok0 + bj * HALF, b = tok >> 13, sp = tok & (SEQ - 1), chunk = sp >> 7, j = sp & 127;
                    bf16_t* p = VT + ((((size_t)(b * 4 + h) * 64 + chunk) * 512 + dv) * 128 + j);
                    *(u32x4*)p = pack8(acc[ai][bj][m][0], acc[ai][bj][m][1]); } }
    }
};

template <class Epi, class Sched, bool ALIGN_EPI = false, bool SP2 = false>
__device__ __forceinline__ void gemm_phase(PG8_LAS unsigned char* lds, const Gemm g, const Sched& S, const Epi& E) {
    const int tid = threadIdx.x, wid = __builtin_amdgcn_readfirstlane(tid >> 6), lane = tid & 63, wr = wid >> 2, wc = wid & 3, fr = lane & 15, fq = lane >> 4;
    const int K = g.K, nt = K / BK;
    unsigned voffA[2], voffB[2];
#pragma unroll
    for (int i = 0; i < 2; ++i) { int R, C; stage_rc(tid * 16 + i * 8192, R, C); const int Rb = Epi::PERM ? ((R & ~31) + perm32(R & 31)) : R;
        voffA[i] = (unsigned)(R * K + C) * 2u; voffB[i] = (unsigned)(Rb * K + C) * 2u; }
    const size_t kstep = (size_t)(BK * 2);
    const size_t hstep = (size_t)HALF * K * 2;
    const size_t tstep = 2 * hstep;
    const unsigned ldsw = (unsigned)wid * 1024u;
    const int aoff = lds_byte(wr * 64 + fr, fq * 8), boff = lds_byte(wc * 32 + fr, fq * 8);
#define PG8_SA(b, h) (((b) * 2 + (h)) * HTB)
#define PG8_SB(b, h) ((4 + (b) * 2 + (h)) * HTB)
#define PG8_STAGE(bufoff, gbase, voff) do { _Pragma("unroll") for (int _i = 0; _i < 2; ++_i) \
        __builtin_amdgcn_global_load_lds((const unsigned*)((const char*)(gbase) + (voff)[_i]), (PG8_LAS unsigned*)(lds + (bufoff) + ldsw + _i * 8192), 16, 0, 0); } while (0)
#define PG8_LDA(dst, b, h) do { _Pragma("unroll") for (int m = 0; m < 4; ++m) _Pragma("unroll") for (int k = 0; k < 2; ++k) dst[m][k] = *(const PG8_LAS bf16x8*)(lds + PG8_SA(b, h) + aoff + m * 2048 + k * 1024); } while (0)
#define PG8_LDB(dst, b, h) do { _Pragma("unroll") for (int n = 0; n < 2; ++n) _Pragma("unroll") for (int k = 0; k < 2; ++k) dst[n][k] = *(const PG8_LAS bf16x8*)(lds + PG8_SB(b, h) + boff + n * 2048 + k * 1024); } while (0)
#define PG8_MMA(ai, bj, At, Bt) do { __builtin_amdgcn_s_setprio(1); _Pragma("unroll") for (int m = 0; m < 4; ++m) _Pragma("unroll") for (int n = 0; n < 2; ++n) _Pragma("unroll") for (int k = 0; k < 2; ++k) \
        acc[ai][bj][m][n] = __builtin_amdgcn_mfma_f32_16x16x32_bf16(Bt[n][k], At[m][k], acc[ai][bj][m][n], 0, 0, 0); __builtin_amdgcn_s_setprio(0); } while (0)
#define PG8_WAIT_V(n) asm volatile("s_waitcnt vmcnt(" #n ")" ::: "memory")
#define PG8_WAIT_L(n) asm volatile("s_waitcnt lgkmcnt(" #n ")" ::: "memory")
#define PG8_BAR __builtin_amdgcn_s_barrier()
#define PG8_SCHED __builtin_amdgcn_sched_barrier(0)
    Unit cur, nxt; int ui = 0;
    if (!S.next(0, cur)) return;
    f32x4 acc[2][2][4][2];
#pragma unroll
    for (int a = 0; a < 2; ++a)
#pragma unroll
        for (int b = 0; b < 2; ++b)
#pragma unroll
            for (int m = 0; m < 4; ++m)
#pragma unroll
                for (int n = 0; n < 2; ++n) acc[a][b][m][n] = (f32x4){0.f, 0.f, 0.f, 0.f};
    bf16x8 At[4][2], B0[2][2], B1[2][2];
    const char* cA = (const char*)g.A + (size_t)cur.pm * tstep; const char* cB = (const char*)g.Bt + (size_t)cur.pn * tstep;
    S.a_ready(cur);
    if constexpr (SP2) {
        PG8_STAGE(PG8_SB(0, 0), cB, voffB); PG8_STAGE(PG8_SB(0, 1), cB + hstep, voffB); PG8_STAGE(PG8_SA(0, 0), cA, voffA); PG8_STAGE(PG8_SA(0, 1), cA + hstep, voffA);
        if (wr == 1) PG8_BAR;
        PG8_WAIT_V(2); PG8_BAR;
        PG8_STAGE(PG8_SB(1, 0), cB + kstep, voffB); PG8_STAGE(PG8_SA(1, 0), cA + kstep, voffA); PG8_STAGE(PG8_SB(1, 1), cB + hstep + kstep, voffB);
        PG8_WAIT_V(6); PG8_BAR;
    } else {
        PG8_STAGE(PG8_SB(0, 0), cB, voffB); PG8_STAGE(PG8_SA(0, 0), cA, voffA); PG8_STAGE(PG8_SB(0, 1), cB + hstep, voffB); PG8_STAGE(PG8_SA(0, 1), cA + hstep, voffA);
        if (wr == 1) PG8_BAR;
        PG8_WAIT_V(4); PG8_BAR;
        PG8_STAGE(PG8_SB(1, 0), cB + kstep, voffB); PG8_STAGE(PG8_SA(1, 0), cA + kstep, voffA); PG8_STAGE(PG8_SB(1, 1), cB + hstep + kstep, voffB);
        PG8_WAIT_V(6); PG8_BAR;
    }
    for (;;) {
        const bool has_next = S.next(ui + 1, nxt);
        const char* nA = has_next ? (const char*)g.A + (size_t)nxt.pm * tstep : cA; const char* nB = has_next ? (const char*)g.Bt + (size_t)nxt.pn * tstep : cB;
        for (int t = 0; t < nt; t += 2) {
            const bool last = (t == nt - 2);
            const char* a1 = cA + (size_t)(t + 1) * kstep;
            const char* a2 = last ? nA : cA + (size_t)(t + 2) * kstep; const char* b2 = last ? nB : cB + (size_t)(t + 2) * kstep;
            const char* a3 = a2 + kstep; const char* b3 = b2 + kstep;
            if (last && has_next) S.a_ready(nxt);
            if constexpr (SP2) {
            PG8_LDB(B0, 0, 0); PG8_LDB(B1, 0, 1); PG8_SCHED; PG8_LDA(At, 0, 0); PG8_STAGE(PG8_SA(1, 1), a1 + hstep, voffA);
            PG8_WAIT_V(8); PG8_WAIT_L(0); PG8_BAR; PG8_MMA(0, 0, At, B0); PG8_MMA(0, 1, At, B1); PG8_BAR; PG8_SCHED;
            PG8_LDA(At, 0, 1); PG8_STAGE(PG8_SB(0, 0), b2, voffB); PG8_STAGE(PG8_SB(0, 1), b2 + hstep, voffB); PG8_STAGE(PG8_SA(0, 0), a2, voffA);
            PG8_WAIT_V(8); PG8_WAIT_L(0); PG8_BAR; PG8_MMA(1, 0, At, B0); PG8_MMA(1, 1, At, B1); PG8_BAR; PG8_SCHED;
            PG8_LDB(B0, 1, 0); PG8_LDB(B1, 1, 1); PG8_SCHED; PG8_LDA(At, 1, 0); PG8_STAGE(PG8_SA(0, 1), a2 + hstep, voffA);
            PG8_WAIT_V(8); PG8_WAIT_L(0); PG8_BAR; PG8_MMA(0, 0, At, B0); PG8_MMA(0, 1, At, B1); PG8_BAR; PG8_SCHED;
            PG8_LDA(At, 1, 1); PG8_STAGE(PG8_SB(1, 0), b3, voffB); PG8_STAGE(PG8_SB(1, 1), b3 + hstep, voffB); PG8_STAGE(PG8_SA(1, 0), a3, voffA);
            PG8_WAIT_V(8); PG8_WAIT_L(0); PG8_BAR; PG8_MMA(1, 0, At, B0); PG8_MMA(1, 1, At, B1); PG8_BAR; PG8_SCHED;
            } else {
            PG8_LDB(B0, 0, 0); PG8_SCHED; PG8_LDA(At, 0, 0); PG8_STAGE(PG8_SA(1, 1), a1 + hstep, voffA);
            PG8_WAIT_L(8); PG8_BAR; PG8_WAIT_L(0); PG8_MMA(0, 0, At, B0); PG8_BAR; PG8_SCHED;
            PG8_LDB(B1, 0, 1); PG8_STAGE(PG8_SB(0, 0), b2, voffB);
            PG8_BAR; PG8_WAIT_L(0); PG8_MMA(0, 1, At, B1); PG8_BAR;
            PG8_LDA(At, 0, 1); PG8_STAGE(PG8_SA(0, 0), a2, voffA);
            PG8_BAR; PG8_WAIT_L(0); PG8_MMA(1, 0, At, B0); PG8_BAR; PG8_SCHED;
            PG8_STAGE(PG8_SB(0, 1), b2 + hstep, voffB);
            PG8_WAIT_V(6); PG8_BAR; PG8_MMA(1, 1, At, B1); PG8_BAR;
            PG8_LDB(B0, 1, 0); PG8_SCHED; PG8_LDA(At, 1, 0); PG8_STAGE(PG8_SA(0, 1), a2 + hstep, voffA);
            PG8_WAIT_L(8); PG8_BAR; PG8_WAIT_L(0); PG8_MMA(0, 0, At, B0); PG8_BAR; PG8_SCHED;
            PG8_LDB(B1, 1, 1); PG8_STAGE(PG8_SB(1, 0), b3, voffB);
            PG8_BAR; PG8_WAIT_L(0); PG8_MMA(0, 1, At, B1); PG8_BAR;
            PG8_LDA(At, 1, 1); PG8_STAGE(PG8_SA(1, 0), a3, voffA);
            PG8_BAR; PG8_WAIT_L(0); PG8_MMA(1, 0, At, B0); PG8_BAR; PG8_SCHED;
            PG8_STAGE(PG8_SB(1, 1), b3 + hstep, voffB);
            PG8_WAIT_V(6); PG8_BAR; PG8_MMA(1, 1, At, B1); PG8_BAR;
            }
        }
        if constexpr (ALIGN_EPI) { if (wr == 0) PG8_BAR; }
        if constexpr (!Epi::AFTER_DRAIN) { E(acc, cur, wr, wc, fr, fq); S.done(cur); }
        if (!has_next) break;
#pragma unroll
        for (int a = 0; a < 2; ++a)
#pragma unroll
            for (int b = 0; b < 2; ++b)
#pragma unroll
                for (int m = 0; m < 4; ++m)
#pragma unroll
                    for (int n = 0; n < 2; ++n) acc[a][b][m][n] = (f32x4){0.f, 0.f, 0.f, 0.f};
        cur = nxt; cA = nA; cB = nB; ++ui;
        if constexpr (ALIGN_EPI) { if (wr == 1) PG8_BAR; }
    }
    PG8_WAIT_V(0);
    if constexpr (!ALIGN_EPI) { if (wr == 0) PG8_BAR; }
    PG8_BAR;
    if constexpr (Epi::AFTER_DRAIN) { E.fused(acc, cur, wr, wc, fr, fq, lds, wid, lane); S.done(cur); }
#undef PG8_SA
#undef PG8_SB
#undef PG8_STAGE
#undef PG8_LDA
#undef PG8_LDB
#undef PG8_MMA
#undef PG8_WAIT_V
#undef PG8_WAIT_L
#undef PG8_BAR
#undef PG8_SCHED
}
}

#define GAS __attribute__((address_space(1)))
#define LAS __attribute__((address_space(3)))
typedef unsigned short bf16;
typedef unsigned v4u __attribute__((ext_vector_type(4)));
typedef float f32x4 __attribute__((ext_vector_type(4)));
typedef short bf16x8 __attribute__((ext_vector_type(8)));
typedef GAS unsigned gu32;
typedef GAS unsigned long long gu64;
#define RLX_AGENT __ATOMIC_RELAXED, __HIP_MEMORY_SCOPE_AGENT
#define LDS_WAIT() asm volatile("s_waitcnt lgkmcnt(0)" ::: "memory")
#define VM_WAIT() asm volatile("s_waitcnt vmcnt(0)" ::: "memory")
__device__ __forceinline__ unsigned long long rt() { return __builtin_amdgcn_s_memrealtime(); }
__device__ __forceinline__ unsigned f2bf(float f) { unsigned u = __builtin_bit_cast(unsigned, f); return (u + 0x7fffu + ((u >> 16) & 1u)) >> 16; }
__device__ __forceinline__ unsigned pk2(float lo, float hi) { return f2bf(lo) | (f2bf(hi) << 16); }
#define XB_TMO      128
#define XB_XCNT(j)  (256  + 64 * (j))
#define XB_XSUB(j)  (1280 + 64 * (j))
#define XB_XGEN(j)  (2304 + 64 * (j))
#define XB_TOP      3328
#define XB_TOPGEN   3392
#define XCD_BAR_WORDS 3456
#define XB_SPIN_CAP (1u << 18)

__device__ __forceinline__ unsigned xb_ld(unsigned* p)              { return __hip_atomic_load(p, __ATOMIC_RELAXED, __HIP_MEMORY_SCOPE_AGENT); }
__device__ __forceinline__ unsigned xb_add(unsigned* p, unsigned v) { return __hip_atomic_fetch_add(p, v, __ATOMIC_RELAXED, __HIP_MEMORY_SCOPE_AGENT); }
__device__ __forceinline__ unsigned xb_xcc_id() { return (unsigned)__builtin_amdgcn_s_getreg((3 << 11) | 20) & 0xFu; }
#define XB_SPIN(cond, bar) do { unsigned _sp = 0; while (cond) { __builtin_amdgcn_s_sleep(1); \
    if ((++_sp & 255u) == 0u) { if (xb_ld(&(bar)[XB_TMO])) break; if (_sp > XB_SPIN_CAP) { atomicAdd(&(bar)[XB_TMO], 1u); break; } } } } while (0)

struct XcdBarrier {
    unsigned* bar; unsigned x;
    volatile LAS unsigned* st;
};

__device__ __forceinline__ XcdBarrier xcd_barrier_post(unsigned* bar, volatile LAS unsigned* st) {
    XcdBarrier b; b.bar = bar; b.x = xb_xcc_id(); b.st = st;
    if (threadIdx.x == 0) (void)xb_add(&bar[XB_XCNT(b.x)], 1u);
    return b;
}
__device__ __forceinline__ void xcd_barrier_complete(unsigned* bar, unsigned x, unsigned& nloc, unsigned& nx) {
    const unsigned G = gridDim.x * gridDim.y * gridDim.z;
    unsigned sum, cnt, mine, sp = 0u;
    for (;;) {
        sum = 0u; cnt = 0u; mine = 0u;
#pragma unroll
        for (unsigned j = 0; j < 16; ++j) { const unsigned c = xb_ld(&bar[XB_XCNT(j)]); sum += c; cnt += (c > 0u) ? 1u : 0u; mine = (j == x) ? c : mine; }
        if (sum == G) break;
        __builtin_amdgcn_s_sleep(1);
        if ((++sp & 255u) == 0u) { if (xb_ld(&bar[XB_TMO])) break; if (sp > XB_SPIN_CAP) { atomicAdd(&bar[XB_TMO], 1u); break; } }
    }
    nloc = mine > 0u ? mine : 1u; nx = cnt > 0u ? cnt : 1u;
}

__device__ __forceinline__ void xcd_barrier(const XcdBarrier& b) {
    asm volatile("s_waitcnt vmcnt(0)" ::: "memory");
    __syncthreads();
    if (threadIdx.x == 0) {
        unsigned* bar = b.bar;
        __builtin_amdgcn_s_waitcnt(0);
        unsigned nloc = b.st[0], nx = b.st[1];
        if (nloc == 0u) { xcd_barrier_complete(bar, b.x, nloc, nx); b.st[0] = nloc; b.st[1] = nx; }
        const unsigned old = xb_add(&bar[XB_XSUB(b.x)], 1u);
        const unsigned gen = old / nloc;
        if (old + 1u == (gen + 1u) * nloc) {
            __builtin_amdgcn_fence(__ATOMIC_RELEASE, "agent");
            asm volatile("s_waitcnt vmcnt(0)" ::: "memory");
            const unsigned og = xb_add(&bar[XB_TOP], 1u);
            const unsigned tg = og / nx;
            if (og + 1u == (tg + 1u) * nx) xb_add(&bar[XB_TOPGEN], 1u);
            else XB_SPIN(xb_ld(&bar[XB_TOPGEN]) == tg, bar);
            __builtin_amdgcn_fence(__ATOMIC_ACQUIRE, "agent");
            xb_add(&bar[XB_XGEN(b.x)], 1u);
            asm volatile("s_waitcnt vmcnt(0)" ::: "memory");
        } else {
            XB_SPIN(xb_ld(&bar[XB_XGEN(b.x)]) == gen, bar);
            __builtin_amdgcn_fence(__ATOMIC_ACQUIRE, "agent");
            asm volatile("s_waitcnt vmcnt(0)" ::: "memory");
        }
    }
    __syncthreads();
}

constexpr size_t MiB = 1u << 20;
constexpr size_t WS_CTL = 0, CTL_ZERO_BYTES = 1 * MiB;
constexpr size_t WS_COS = 1 * MiB, WS_SIN = 5 * MiB;
constexpr size_t WS_MODS = 9 * MiB;
constexpr size_t WS_KVMOD = 9 * MiB + 256 * 1024;
constexpr size_t WS_SCQ = 9 * MiB + 320 * 1024, WS_SCK = WS_SCQ + 4096, WS_SCG = WS_SCQ + 8192;
constexpr size_t WS_BIAS = 9 * MiB + 384 * 1024;
constexpr size_t WS_WT_IN = 10 * MiB, WS_WT_OUT = 22 * MiB, WS_WT_UP = 26 * MiB, WS_WT_DOWN = 37 * MiB, WS_WT_KV = 43 * MiB;
constexpr size_t WS_KSH = 44 * MiB, WS_VSH = 52 * MiB;
constexpr size_t WS_R = 60 * MiB;
constexpr size_t WS_BIG = 188 * MiB;
constexpr size_t WS_END = 380 * MiB;
constexpr int CW_TMO = 0, CW_BAR = 4096;

constexpr int RING_OFF = 0, RING_BYTES = 131072;
constexpr int LDSCTL_OFF = RING_BYTES, MISC_OFF = LDSCTL_OFF + 320;
constexpr int LDS_BYTES = 147456;
constexpr int NWAVES = 8;

__constant__ unsigned char T5_BUCKET[128] = {0, 1, 2, 3, 4, 5, 6, 7, 8, 9, 10, 11, 12, 13, 14, 15, 16, 16, 16, 17, 17, 18, 18, 18, 19, 19, 19, 20, 20, 20, 20, 21, 21, 21, 21, 22, 22, 22, 22, 22, 23, 23, 23, 23, 23, 23, 24, 24, 24, 24, 24, 24, 25, 25, 25, 25, 25, 25, 25, 26, 26, 26, 26, 26, 26, 26, 26, 27, 27, 27, 27, 27, 27, 27, 27, 27, 27, 28, 28, 28, 28, 28, 28, 28, 28, 28, 28, 29, 29, 29, 29, 29, 29, 29, 29, 29, 29, 29, 29, 30, 30, 30, 30, 30, 30, 30, 30, 30, 30, 30, 30, 30, 30, 31, 31, 31, 31, 31, 31, 31, 31, 31, 31, 31, 31, 31, 31, 31};

struct Frame {
    LAS unsigned char* lds;
    volatile LAS unsigned* MISC;
    gu32* ctl;
    int tid, lane, wave, vcu, G;
    unsigned char* ws;
    const float* __attribute__((address_space(4)))* in;
    float* out;
};
enum { I_X = 0, I_C, I_NORMG, I_ADAW, I_ADAB, I_RWIN, I_RWOUT, I_KVNG, I_KVADAW, I_KVADAB, I_KVW, I_SWQ, I_SWO, I_SINKS, I_RELB, I_WUP, I_CONVW, I_CONVB, I_WDOWN };

__device__ __forceinline__ float bf2f(bf16 h) { return __uint_as_float(((unsigned)h) << 16); }
__device__ __forceinline__ float wave_sum(float v) {
#pragma unroll
    for (int o = 1; o < 64; o <<= 1) v += __shfl_xor(v, o);
    return v;
}
__device__ __forceinline__ float wave_max(float v) {
#pragma unroll
    for (int o = 1; o < 64; o <<= 1) v = fmaxf(v, __shfl_xor(v, o));
    return v;
}
__device__ __forceinline__ float dot8(const v4u a, const v4u b) {
    float s = 0.f;
#pragma unroll
    for (int e = 0; e < 4; ++e) { s += __uint_as_float(a[e] << 16) * __uint_as_float(b[e] << 16); s += __uint_as_float(a[e] & 0xffff0000u) * __uint_as_float(b[e] & 0xffff0000u); }
    return s;
}
__device__ __forceinline__ float silu(float x) { return x * __builtin_amdgcn_rcpf(1.0f + __expf(-x)); }

__device__ __forceinline__ void phase_mods(Frame& F) {
    LAS float* cact = (LAS float*)(F.lds);
    LAS float* part = (LAS float*)(F.lds + 8192);
    for (int i = F.tid; i < 2 * D; i += 512) cact[i] = silu(F.in[I_C][i]);
    __syncthreads();
    const int item = F.vcu;
    const float* W = nullptr; const float* bias = nullptr; float* outp = nullptr; int N = 0, ostride = 0;
    if (item < 208) {
        const int col0 = item * 128;
        if (col0 < 4 * 6144) { const int l = col0 / 6144, cl = col0 % 6144; W = F.in[I_ADAW] + (size_t)l * D * 6144 + cl; N = 6144; bias = F.in[I_ADAB] + l * 6144 + cl; outp = (float*)(F.ws + WS_MODS) + l * 2 * 6144 + cl; ostride = 6144; }
        else { const int cl = col0 - 4 * 6144; W = F.in[I_KVADAW] + cl; N = 2048; bias = F.in[I_KVADAB] + cl; outp = (float*)(F.ws + WS_KVMOD) + cl; ostride = 2048; }
        const int cg = F.wave & 1, kq = F.wave >> 1, col = 64 * cg + F.lane, k0 = kq * 256;
        float a0 = 0.f, a1 = 0.f;
#pragma unroll 8
        for (int k = k0; k < k0 + 256; ++k) { const float w = W[(size_t)k * N + col]; a0 += w * cact[k]; a1 += w * cact[D + k]; }
        part[(F.wave * 2 + 0) * 64 + F.lane] = a0; part[(F.wave * 2 + 1) * 64 + F.lane] = a1;
    }
    __syncthreads();
    if (item < 208 && F.tid < 256) {
        const int b = F.tid >> 7, col = F.tid & 127, cg = col >> 6, ln = col & 63; float s = 0.f;
#pragma unroll
        for (int kq = 0; kq < 4; ++kq) s += part[(((kq << 1) | cg) * 2 + b) * 64 + ln];
        outp[b * ostride + col] = s + bias[col];
    }
    __syncthreads();
}
__device__ __forceinline__ void sincos_d(double a, double& s, double& c) {
    const double k = __builtin_rint(a * 0.6366197723675814);
    double r = __builtin_fma(-k, 1.5707963267948966, a); r = __builtin_fma(-k, 6.123233995736766e-17, r);
    const double r2 = r * r;
    double sp = 1.0 / 6227020800.0; sp = sp * r2 - 1.0 / 39916800.0; sp = sp * r2 + 1.0 / 362880.0; sp = sp * r2 - 1.0 / 5040.0; sp = sp * r2 + 1.0 / 120.0; sp = sp * r2 - 1.0 / 6.0; sp = r + r * r2 * sp;
    double cp = -1.0 / 87178291200.0; cp = cp * r2 + 1.0 / 479001600.0; cp = cp * r2 - 1.0 / 3628800.0; cp = cp * r2 + 1.0 / 40320.0; cp = cp * r2 - 1.0 / 720.0; cp = cp * r2 + 1.0 / 24.0; cp = cp * r2 - 0.5; cp = 1.0 + r2 * cp;
    const int q = ((int)k) & 3;
    s = (q == 0) ? sp : (q == 1) ? cp : (q == 2) ? -sp : -cp;
    c = (q == 0) ? cp : (q == 1) ? -sp : (q == 2) ? -cp : sp;
}
__device__ __forceinline__ void phase_tables(Frame& F) {
    float* cosT = (float*)(F.ws + WS_COS); float* sinT = (float*)(F.ws + WS_SIN);
    const int NT = F.G * 512;
    for (int idx = F.vcu * 512 + F.tid; idx < SEQ * 128; idx += NT) {
        const int pos = idx >> 7, i = idx & 127;
        double inv = 1.0, r = 0.930572040929699;
#pragma unroll
        for (int bit = 0; bit < 7; ++bit) { if ((i >> bit) & 1) inv *= r; r *= r; }
        double s, c; sincos_d((double)pos * inv, s, c);
        cosT[idx] = (float)c; sinT[idx] = (float)s;
    }
    if (F.vcu == F.G - 1) {
        float* scq = (float*)(F.ws + WS_SCQ); float* sck = (float*)(F.ws + WS_SCK); float* scg = (float*)(F.ws + WS_SCG); float* bias = (float*)(F.ws + WS_BIAS);
        { const int h = F.tid >> 7, p = F.tid & 127; double gam = 1.0 - 1.0 / (double)(32 << h), g = 1.0;
          for (int e = 0; e <= p; ++e) g *= gam;
          scq[F.tid] = (float)g; sck[F.tid] = (float)(0.0625 / g);
          if (p == 127) scg[h] = (float)g; }
        for (int idx = F.tid; idx < 16 * 128; idx += 512) { const int head = idx >> 7, dist = idx & 127; bias[idx] = F.in[I_RELB][(int)T5_BUCKET[dist] * 16 + head]; }
    }
}
__device__ __forceinline__ void transpose_item(const float* W, int K, int N, bf16* WT, LAS float* scr, int item, int lane, int mode) {
    const int nblk = N / 32, kb = item / nblk, nb = item % nblk, k0 = 64 * kb, n0 = 32 * nb;
    int r0 = n0; if (mode == 1) r0 = n0 < 2048 ? n0 : (n0 < 4096 ? n0 + 2048 : n0 - 2048);
#pragma unroll 8
    for (int i = 0; i < 32; ++i) { const int kk = 2 * i + (lane >> 5); scr[kk * 33 + (lane & 31)] = W[(size_t)(k0 + kk) * N + n0 + (lane & 31)]; }
    LDS_WAIT(); asm volatile("" ::: "memory");
    const int c = lane & 7;
#pragma unroll
    for (int j = 0; j < 4; ++j) { const int n = (lane >> 3) + 8 * j; const LAS float* s = scr + (8 * c) * 33 + n;
        v4u o; o.x = pk2(s[0 * 33], s[1 * 33]); o.y = pk2(s[2 * 33], s[3 * 33]); o.z = pk2(s[4 * 33], s[5 * 33]); o.w = pk2(s[6 * 33], s[7 * 33]);
        *(GAS v4u*)(WT + (size_t)(r0 + n) * K + k0 + 8 * c) = o; }
    LDS_WAIT(); asm volatile("" ::: "memory");
}
__device__ __forceinline__ void phase_weights(Frame& F, int layer) {
    LAS float* scr = (LAS float*)(F.lds + RING_OFF + F.wave * 16384);
    const int gw = F.vcu * NWAVES + F.wave, NGW = F.G * NWAVES;
    const bool ret = layer < 2; const int li = ret ? layer : layer - 2;
    const float* w0 = ret ? F.in[I_RWIN] + (size_t)li * D * RETN : F.in[I_SWQ] + (size_t)li * D * D;        const int K0 = D, N0 = ret ? RETN : D;
    const float* w1 = ret ? F.in[I_RWOUT] + (size_t)li * 2048 * D : F.in[I_SWO] + (size_t)li * D * D;       const int K1 = ret ? 2048 : D, N1 = D;
    const float* w2 = F.in[I_WUP] + (size_t)layer * D * FF2;   const int K2 = D, N2 = FF2;
    const float* w3 = F.in[I_WDOWN] + (size_t)layer * FF * D;  const int K3 = FF, N3 = D;
    const int i0 = (K0 / 64) * (N0 / 32), i1 = (K1 / 64) * (N1 / 32), i2 = (K2 / 64) * (N2 / 32), i3 = (K3 / 64) * (N3 / 32), i4 = (layer == 2) ? (D / 64) * (512 / 32) : 0;
    const int total = i0 + i1 + i2 + i3 + i4;
    for (int it = gw; it < total; it += NGW) {
        int r = it;
        if (r < i0) { transpose_item(w0, K0, N0, (bf16*)(F.ws + WS_WT_IN), scr, r, F.lane, ret ? 1 : 0); continue; } r -= i0;
        if (r < i1) { transpose_item(w1, K1, N1, (bf16*)(F.ws + WS_WT_OUT), scr, r, F.lane, 0); continue; } r -= i1;
        if (r < i2) { transpose_item(w2, K2, N2, (bf16*)(F.ws + WS_WT_UP), scr, r, F.lane, 0); continue; } r -= i2;
        if (r < i3) { transpose_item(w3, K3, N3, (bf16*)(F.ws + WS_WT_DOWN), scr, r, F.lane, 0); continue; } r -= i3;
        transpose_item(F.in[I_KVW], D, 512, (bf16*)(F.ws + WS_WT_KV), scr, r, F.lane, 0);
    }
}

struct RowPass {
    const float* xsrc; float* xdst; const bf16* y; const float* gpost; const float* gate; int gstride;
    bf16* h1; const float* g1; const float* sc1; const float* sh1; int st1;
    bf16* h2; const float* g2; const float* sc2; const float* sh2; int st2;
};
__device__ __forceinline__ void phase_rowpass(Frame& F, const RowPass& P) {
    const int gw = F.vcu * NWAVES + F.wave, NGW = F.G * NWAVES;
    const int c0 = 4 * F.lane;
    for (int bb = 0; bb < BATCH; ++bb) {
        f32x4 cA[4], cB1[4], cC1[4], cB2[4], cC2[4];
#pragma unroll
        for (int j = 0; j < 4; ++j) {
            const int c = c0 + 256 * j;
            if (P.y) { const f32x4 g = *(const f32x4*)(P.gpost + c), t = *(const f32x4*)(P.gate + bb * P.gstride + c); cA[j] = g * (t + 1.0f); } else cA[j] = (f32x4){0.f, 0.f, 0.f, 0.f};
            if (P.h1) { const f32x4 g = *(const f32x4*)(P.g1 + c), s = *(const f32x4*)(P.sc1 + bb * P.st1 + c); cB1[j] = g * (s + 1.0f); cC1[j] = *(const f32x4*)(P.sh1 + bb * P.st1 + c); } else { cB1[j] = (f32x4){0.f, 0.f, 0.f, 0.f}; cC1[j] = cB1[j]; }
            if (P.h2) { const f32x4 g = *(const f32x4*)(P.g2 + c), s = *(const f32x4*)(P.sc2 + bb * P.st2 + c); cB2[j] = g * (s + 1.0f); cC2[j] = *(const f32x4*)(P.sh2 + bb * P.st2 + c); } else { cB2[j] = (f32x4){0.f, 0.f, 0.f, 0.f}; cC2[j] = cB2[j]; }
        }
        for (int m = bb * SEQ + gw; m < (bb + 1) * SEQ; m += NGW) {
            f32x4 x[4];
#pragma unroll
            for (int j = 0; j < 4; ++j) x[j] = *(const f32x4*)(P.xsrc + (size_t)m * D + c0 + 256 * j);
            if (P.y) {
                f32x4 yv[4]; float ss = 0.f;
#pragma unroll
                for (int j = 0; j < 4; ++j) { const uint2 w = *(const uint2*)(P.y + (size_t)m * D + c0 + 256 * j);
                    yv[j] = (f32x4){__uint_as_float(w.x << 16), __uint_as_float(w.x & 0xffff0000u), __uint_as_float(w.y << 16), __uint_as_float(w.y & 0xffff0000u)};
                    ss += (yv[j][0] * yv[j][0] + yv[j][1] * yv[j][1]) + (yv[j][2] * yv[j][2] + yv[j][3] * yv[j][3]); }
                const float rstd = __builtin_amdgcn_rsqf(wave_sum(ss) * (1.0f / D) + NORM_EPS);
#pragma unroll
                for (int j = 0; j < 4; ++j) x[j] = x[j] + cA[j] * yv[j] * rstd;
            }
            if (P.xdst) {
#pragma unroll
                for (int j = 0; j < 4; ++j) *(f32x4*)(P.xdst + (size_t)m * D + c0 + 256 * j) = x[j];
            }
            if (P.h1 || P.h2) {
                float ss = 0.f;
#pragma unroll
                for (int j = 0; j < 4; ++j) ss += (x[j][0] * x[j][0] + x[j][1] * x[j][1]) + (x[j][2] * x[j][2] + x[j][3] * x[j][3]);
                const float rstd = __builtin_amdgcn_rsqf(wave_sum(ss) * (1.0f / D) + NORM_EPS);
                if (P.h1) {
#pragma unroll
                    for (int j = 0; j < 4; ++j) { const f32x4 h = x[j] * rstd * cB1[j] + cC1[j]; uint2 w; w.x = pk2(h[0], h[1]); w.y = pk2(h[2], h[3]); *(uint2*)(P.h1 + (size_t)m * D + c0 + 256 * j) = w; }
                }
                if (P.h2) {
#pragma unroll
                    for (int j = 0; j < 4; ++j) { const f32x4 h = x[j] * rstd * cB2[j] + cC2[j]; uint2 w; w.x = pk2(h[0], h[1]); w.y = pk2(h[2], h[3]); *(uint2*)(P.h2 + (size_t)m * D + c0 + 256 * j) = w; }
                }
            }
        }
    }
}

__device__ __forceinline__ void phase_conv(Frame& F, int layer) {
    const bf16* U = (const bf16*)(F.ws + WS_BIG); bf16* A = (bf16*)(F.ws + WS_R);
    const float* cw = F.in[I_CONVW] + (size_t)layer * 3 * FF2; const float* cb = F.in[I_CONVB] + (size_t)layer * FF2;
    const int gw = F.vcu * NWAVES + F.wave, NGW = F.G * NWAVES;
    constexpr int NSEG = M / 16, NHT = NSEG * 11, NWT = NHT / 2;
    for (int wt = gw; wt < NWT; wt += NGW) {
        const int ht = 2 * wt + (F.lane >> 5), cgb = ht % 11, seg = ht / 11, c0 = (cgb * 32 + (F.lane & 31)) * 8, m0 = seg * 16;
        f32x4 wg[3][2], wv[3][2], bg[2], bv[2];
#pragma unroll
        for (int h = 0; h < 2; ++h) {
#pragma unroll
            for (int j = 0; j < 3; ++j) { wg[j][h] = *(const f32x4*)(cw + j * FF2 + c0 + 4 * h); wv[j][h] = *(const f32x4*)(cw + j * FF2 + FF + c0 + 4 * h); }
            bg[h] = *(const f32x4*)(cb + c0 + 4 * h); bv[h] = *(const f32x4*)(cb + FF + c0 + 4 * h);
        }
        v4u g1, g2, v1, v2;
        if ((m0 & (SEQ - 1)) == 0) { g1 = g2 = v1 = v2 = (v4u){0u, 0u, 0u, 0u}; }
        else { g1 = *(const v4u*)(U + (size_t)(m0 - 1) * FF2 + c0); v1 = *(const v4u*)(U + (size_t)(m0 - 1) * FF2 + FF + c0); g2 = *(const v4u*)(U + (size_t)(m0 - 2) * FF2 + c0); v2 = *(const v4u*)(U + (size_t)(m0 - 2) * FF2 + FF + c0); }
#pragma unroll 4
        for (int r = 0; r < 16; ++r) {
            const int m = m0 + r;
            const v4u g0 = *(const v4u*)(U + (size_t)m * FF2 + c0), v0 = *(const v4u*)(U + (size_t)m * FF2 + FF + c0);
            v4u o;
#pragma unroll
            for (int e = 0; e < 4; ++e) {
                const int h = e >> 1, q = (e & 1) * 2;
                const float ga = bg[h][q] + wg[0][h][q] * __uint_as_float(g2[e] << 16) + wg[1][h][q] * __uint_as_float(g1[e] << 16) + wg[2][h][q] * __uint_as_float(g0[e] << 16);
                const float gb = bg[h][q + 1] + wg[0][h][q + 1] * __uint_as_float(g2[e] & 0xffff0000u) + wg[1][h][q + 1] * __uint_as_float(g1[e] & 0xffff0000u) + wg[2][h][q + 1] * __uint_as_float(g0[e] & 0xffff0000u);
                const float va = bv[h][q] + wv[0][h][q] * __uint_as_float(v2[e] << 16) + wv[1][h][q] * __uint_as_float(v1[e] << 16) + wv[2][h][q] * __uint_as_float(v0[e] << 16);
                const float vb = bv[h][q + 1] + wv[0][h][q + 1] * __uint_as_float(v2[e] & 0xffff0000u) + wv[1][h][q + 1] * __uint_as_float(v1[e] & 0xffff0000u) + wv[2][h][q + 1] * __uint_as_float(v0[e] & 0xffff0000u);
                o[e] = pk2(silu(ga) * va, silu(gb) * vb);
            }
            *(v4u*)(A + (size_t)m * FF + c0) = o;
            g2 = g1; g1 = g0; v2 = v1; v1 = v0;
        }
    }
}

__device__ __forceinline__ void pass1_naive(Frame& F) {
    const bf16* KT = (const bf16*)(F.ws + WS_BIG + 32 * MiB); const bf16* VT = (const bf16*)(F.ws + WS_BIG + 64 * MiB); bf16* RS = (bf16*)(F.ws + WS_R);
    const float* scg = (const float*)(F.ws + WS_SCG);
    for (int vt = F.vcu * 512 + F.tid; vt < 8 * 256 * 64; vt += F.G * 512) {
        const int bh = vt >> 14, rem = vt & 16383, dk = rem & 255, dv0 = (rem >> 8) * 8, b = bh >> 2, h = bh & 3;
        const float gch = scg[h];
        float R[8];
#pragma unroll
        for (int e = 0; e < 8; ++e) R[e] = 0.f;
        const bf16* kp = KT + (size_t)(b * SEQ) * 1024 + h * 256 + dk;
        for (int n = 0; n < NCH; ++n) {
            bf16* rb = RS + (((size_t)bh * 64 + n) * 512 + dv0) * 256 + dk;
#pragma unroll
            for (int e = 0; e < 8; ++e) rb[e * 256] = (bf16)f2bf(R[e]);
            if (n == NCH - 1) break;
            const bf16* vp = VT + (((size_t)bh * 64 + n) * 512 + dv0) * 128;
            float u[8];
#pragma unroll
            for (int e = 0; e < 8; ++e) u[e] = 0.f;
            for (int j0 = 0; j0 < 128; j0 += 8) {
                float kv[8];
#pragma unroll
                for (int jj = 0; jj < 8; ++jj) kv[jj] = bf2f(kp[(size_t)(n * 128 + j0 + jj) * 1024]);
#pragma unroll
                for (int e = 0; e < 8; ++e) { const v4u w = *(const v4u*)(vp + e * 128 + j0);
#pragma unroll
                    for (int q = 0; q < 4; ++q) { u[e] += kv[2 * q] * __uint_as_float(w[q] << 16); u[e] += kv[2 * q + 1] * __uint_as_float(w[q] & 0xffff0000u); } }
            }
#pragma unroll
            for (int e = 0; e < 8; ++e) R[e] = gch * (R[e] + u[e]);
        }
    }
}
__device__ __forceinline__ void pass2_naive(Frame& F) {
    const bf16* QT = (const bf16*)(F.ws + WS_BIG); const bf16* KT = (const bf16*)(F.ws + WS_BIG + 32 * MiB); const bf16* VT = (const bf16*)(F.ws + WS_BIG + 64 * MiB);
    bf16* G = (bf16*)(F.ws + WS_BIG + 128 * MiB); const bf16* RS = (const bf16*)(F.ws + WS_R);
    LAS bf16* P = (LAS bf16*)F.lds;
    for (int it = F.vcu; it < 512; it += F.G) {
        const int bh = (it & 255) >> 5, n = (it & 31) + 32 * (it >> 8), b = bh >> 2, h = bh & 3;
        const bf16* q = QT + (size_t)(b * SEQ + n * 128) * 1024 + h * 256; const bf16* k = KT + (size_t)(b * SEQ + n * 128) * 1024 + h * 256;
        for (int e = F.tid; e < 128 * 128; e += 512) {
            const int i = e >> 7, j = e & 127; float s = 0.f;
            if (j <= i) { const v4u* qi = (const v4u*)(q + (size_t)i * 1024); const v4u* kj = (const v4u*)(k + (size_t)j * 1024);
                for (int c = 0; c < 32; ++c) s += dot8(qi[c], kj[c]); }
            P[e] = (bf16)f2bf(s);
        }
        __syncthreads();
        for (int rr = 0; rr < 16; ++rr) {
            const int i = F.wave + 8 * rr; float o[8]; float sum = 0.f;
            const v4u* qrow = (const v4u*)(q + (size_t)i * 1024); const LAS v4u* prow = (const LAS v4u*)(P + i * 128);
#pragma unroll
            for (int e = 0; e < 8; ++e) {
                const int dv = F.lane + 64 * e;
                const v4u* vrow = (const v4u*)(VT + (((size_t)bh * 64 + n) * 512 + dv) * 128); const v4u* rrow = (const v4u*)(RS + (((size_t)bh * 64 + n) * 512 + dv) * 256);
                float s = 0.f;
                for (int c = 0; c < 16; ++c) s += dot8(prow[c], vrow[c]);
                for (int c = 0; c < 32; ++c) s += dot8(qrow[c], rrow[c]);
                o[e] = s; sum += s;
            }
            const float mu = wave_sum(sum) * (1.0f / 512.0f); float sq = 0.f;
#pragma unroll
            for (int e = 0; e < 8; ++e) { o[e] -= mu; sq += o[e] * o[e]; }
            const float rstd = __builtin_amdgcn_rsqf(wave_sum(sq) * (1.0f / 512.0f) + NORM_EPS);
#pragma unroll
            for (int e = 0; e < 8; ++e) { bf16* gp = G + (size_t)(b * SEQ + n * 128 + i) * 2048 + h * 512 + F.lane + 64 * e; *gp = (bf16)f2bf(bf2f(*gp) * o[e] * rstd); }
        }
        __syncthreads();
    }
}
__device__ __forceinline__ void attn_naive(Frame& F, int li) {
    bf16* Q = (bf16*)(F.ws + WS_BIG); const bf16* KS = (const bf16*)(F.ws + WS_KSH); const bf16* VS = (const bf16*)(F.ws + WS_VSH);
    const float* biasT = (const float*)(F.ws + WS_BIAS); const float* sinks = F.in[I_SINKS] + li * 16;
    LAS float* qs = (LAS float*)(F.lds) + F.wave * 256;
    const int gw = F.vcu * NWAVES + F.wave, NGW = F.G * NWAVES;
    for (int item = gw; item < M * SHEADS; item += NGW) {
        const int m = item >> 4, head = item & 15, hk = head >> 2, b = m >> 13, s = m & (SEQ - 1);
        bf16* qp = Q + (size_t)m * 1024 + head * 64 + F.lane;
        qs[F.lane] = bf2f(*qp);
        const float sink = sinks[head];
        float sc[2]; bool valid[2];
#pragma unroll
        for (int t = 0; t < 2; ++t) {
            const int kk = F.lane + 64 * t, kpos = s - 127 + kk, dist = 127 - kk; valid[t] = kpos >= 0; float d = 0.f;
            if (valid[t]) { const v4u* kr = (const v4u*)(KS + (size_t)(b * SEQ + kpos) * 256 + hk * 64);
#pragma unroll
                for (int c = 0; c < 8; ++c) { const v4u w = kr[c];
#pragma unroll
                    for (int e = 0; e < 4; ++e) { d += qs[c * 8 + 2 * e] * __uint_as_float(w[e] << 16); d += qs[c * 8 + 2 * e + 1] * __uint_as_float(w[e] & 0xffff0000u); } } }
            sc[t] = valid[t] ? d * 0.125f + biasT[head * 128 + dist] : -INFINITY;
        }
        const float mx = fmaxf(wave_max(fmaxf(sc[0], sc[1])), sink);
        const float e0 = valid[0] ? __expf(sc[0] - mx) : 0.f, e1 = valid[1] ? __expf(sc[1] - mx) : 0.f;
        const float den = wave_sum(e0 + e1) + __expf(sink - mx), rden = 1.0f / den;
        qs[64 + F.lane] = e0 * rden; qs[128 + F.lane] = e1 * rden;
        float o = 0.f; const int kk0 = (127 - s) > 0 ? (127 - s) : 0;
        const bf16* vp = VS + (size_t)(b * SEQ + s - 127) * 256 + hk * 64 + F.lane;
        for (int kk = kk0; kk < 128; ++kk) o += qs[64 + kk] * bf2f(vp[(size_t)kk * 256]);
        *qp = (bf16)f2bf(o);
    }
}

constexpr int N_PHASES = 2 + 2 * 9 + 2 * 8;
struct Args { const float* in[19]; float* out; unsigned char* ws; int ph_lo, ph_hi; };
static_assert(sizeof(Args) == 19 * 8 + 8 + 8 + 8, "Args has no padding");

__global__ void __launch_bounds__(NWAVES * 64, 2) yoco_fwd(Args args) {
    extern __shared__ __attribute__((aligned(16))) unsigned char lds[];
    Frame F;
    F.lds = (LAS unsigned char*)lds;
    F.MISC = (volatile LAS unsigned*)(F.lds + MISC_OFF);
    F.G = gridDim.x; { const int bx = blockIdx.x; F.vcu = (F.G % 8 == 0) ? (bx % 8) * (F.G / 8) + bx / 8 : bx; }
    for (int u = threadIdx.x; u < (LDS_BYTES - LDSCTL_OFF) / 4; u += NWAVES * 64) ((LAS unsigned*)(F.lds + LDSCTL_OFF))[u] = 0u;
    __syncthreads();
    XcdBarrier bar; bar.bar = (unsigned*)(args.ws + WS_CTL) + CW_BAR; bar.x = 0; bar.st = nullptr;
    if (MK_N_LAUNCHES == 1) bar = xcd_barrier_post((unsigned*)(args.ws + WS_CTL) + CW_BAR, F.MISC + 8);

    int ph_first = args.ph_lo;
    if (ph_first == 0) {
        { int tid = threadIdx.x; asm volatile("" : "+v"(tid)); F.tid = tid; F.lane = tid & 63; F.wave = __builtin_amdgcn_readfirstlane(tid >> 6); }
        const Args __attribute__((address_space(4)))* ap = (const Args __attribute__((address_space(4)))*)__builtin_amdgcn_kernarg_segment_ptr();
        asm volatile("" : "+s"(ap));
        F.in = (const float* __attribute__((address_space(4)))*)&ap->in[0]; F.out = ap->out; F.ws = ap->ws; F.ctl = (gu32*)(F.ws + WS_CTL);
        phase_mods(F); phase_tables(F); phase_weights(F, 0);
        if (args.ph_hi > 1) { if (MK_N_LAUNCHES == 1) xcd_barrier(bar); }
        ph_first = 1;
    }
    for (int ph = ph_first; ph < args.ph_hi; ++ph) {
        { int tid = threadIdx.x; asm volatile("" : "+v"(tid)); F.tid = tid; F.lane = tid & 63; F.wave = __builtin_amdgcn_readfirstlane(tid >> 6); }
        const Args __attribute__((address_space(4)))* ap = (const Args __attribute__((address_space(4)))*)__builtin_amdgcn_kernarg_segment_ptr();
        asm volatile("" : "+s"(ap));
        F.in = (const float* __attribute__((address_space(4)))*)&ap->in[0]; F.out = ap->out; F.ws = ap->ws; F.ctl = (gu32*)(F.ws + WS_CTL);
        unsigned char* ws = F.ws;
        bf16* const H = (bf16*)(ws + WS_R); bf16* const HKV = (bf16*)(ws + WS_R + 32 * MiB); bf16* const ACT = (bf16*)(ws + WS_R);
        bf16* const BIG = (bf16*)(ws + WS_BIG);
        const float* const MODS = (const float*)(ws + WS_MODS); const float* const KVMOD = (const float*)(ws + WS_KVMOD);
        int layer = -1, sub = -1;
        if (ph >= 2) { int p = ph - 2; if (p < 18) { layer = p / 9; sub = p % 9; } else { p -= 18; layer = 2 + p / 8; sub = 10 + p % 8; } }
        const bool ret = layer >= 0 && layer < 2;
        const bool is_rp_start = (ph == 1);
        const bool is_rp_mid = (sub == 4) || (sub == 13);
        const bool is_rp_end = (sub == 8) || (sub == 17);
        const bool is_conv = (sub == 6) || (sub == 15);
        const bool is_gemm_out = (sub == 3) || (sub == 12);
        const bool is_gemm_up = (sub == 5) || (sub == 14);
        const bool is_gemm_down = (sub == 7) || (sub == 16);
        const bool is_gemm_q = (sub == 10);

        if (is_rp_start || is_rp_mid || is_rp_end) {
            RowPass P{};
            if (is_rp_start) {
                P.xsrc = F.in[I_X]; P.xdst = nullptr; P.y = nullptr;
                P.h1 = H; P.g1 = F.in[I_NORMG] + (0 * 4 + 0) * D; P.sc1 = MODS + 1 * D; P.sh1 = MODS + 0 * D; P.st1 = 6144;
            } else if (is_rp_mid) {
                P.xsrc = (layer == 0) ? F.in[I_X] : F.out; P.xdst = F.out;
                P.y = ret ? BIG : BIG + (size_t)16 * MiB;
                P.gpost = F.in[I_NORMG] + (layer * 4 + 1) * D; P.gate = MODS + (size_t)layer * 2 * 6144 + 2 * D; P.gstride = 6144;
                P.h1 = H; P.g1 = F.in[I_NORMG] + (layer * 4 + 2) * D; P.sc1 = MODS + (size_t)layer * 2 * 6144 + 4 * D; P.sh1 = MODS + (size_t)layer * 2 * 6144 + 3 * D; P.st1 = 6144;
            } else {
                P.xsrc = F.out; P.xdst = F.out; P.y = BIG;
                P.gpost = F.in[I_NORMG] + (layer * 4 + 3) * D; P.gate = MODS + (size_t)layer * 2 * 6144 + 5 * D; P.gstride = 6144;
                if (layer < 3) { P.h1 = H; P.g1 = F.in[I_NORMG] + ((layer + 1) * 4 + 0) * D; P.sc1 = MODS + (size_t)(layer + 1) * 2 * 6144 + 1 * D; P.sh1 = MODS + (size_t)(layer + 1) * 2 * 6144; P.st1 = 6144; }
                if (layer == 1) { P.h2 = HKV; P.g2 = F.in[I_KVNG]; P.sc2 = KVMOD + D; P.sh2 = KVMOD; P.st2 = 2048; }
            }
            phase_rowpass(F, P);
            if (is_rp_end && layer < 3) phase_weights(F, layer + 1);
        }

        if (sub == 0) {
            {
                pg8::Gemm g{H, (const bf16*)(ws + WS_WT_IN), M, 4096, D}; pg8::StaticOrder S; S.init(M, 4096, F.G, (int)blockIdx.x);
                pg8::EpiRetQKG E{BIG, BIG + (size_t)16 * MiB, BIG + (size_t)64 * MiB, (const float*)(ws + WS_COS), (const float*)(ws + WS_SIN), (const float*)(ws + WS_SCQ), (const float*)(ws + WS_SCK)};
                pg8::gemm_phase<pg8::EpiRetQKG, pg8::StaticOrder, true, true>(F.lds + RING_OFF, g, S, E);
            }
            {
                pg8::Gemm g{(const bf16*)(ws + WS_WT_IN) + (size_t)4096 * D, H, 2048, M, D}; pg8::StaticOrder S; S.init(2048, M, F.G, (int)blockIdx.x);
                pg8::EpiVT E{BIG + (size_t)32 * MiB};
                pg8::gemm_phase<pg8::EpiVT, pg8::StaticOrder, true, true>(F.lds + RING_OFF, g, S, E);
            }
        }
        if (sub == 1) { pass1_naive(F); }
        if (sub == 2) { pass2_naive(F); }
        if (sub == 11) { attn_naive(F, layer - 2); }
        if (is_conv) { phase_conv(F, layer); }

        if (is_gemm_out || is_gemm_up || is_gemm_down || is_gemm_q) {
            const int ng = (is_gemm_q && layer == 2) ? 2 : 1;
            for (int gi = 0; gi < ng; ++gi) {
                pg8::Gemm g{}; pg8::EpiBf16S E{};
                E.scale = 1.0f; E.split_cols = 0; E.split_stride = 0;
                if (is_gemm_q) {
                    if (gi == 0) { g = pg8::Gemm{H, (const bf16*)(ws + WS_WT_IN), M, D, D}; E.O = BIG; E.ldc = D; }
                    else { g = pg8::Gemm{HKV, (const bf16*)(ws + WS_WT_KV), M, 512, D}; E.O = (bf16*)(ws + WS_KSH); E.ldc = 256; E.split_cols = 256; E.split_stride = (WS_VSH - WS_KSH) / 2; }
                } else if (is_gemm_out) {
                    if (ret) { g = pg8::Gemm{BIG + (size_t)64 * MiB, (const bf16*)(ws + WS_WT_OUT), M, D, 2048}; E.O = BIG; E.ldc = D; }
                    else { g = pg8::Gemm{BIG, (const bf16*)(ws + WS_WT_OUT), M, D, D}; E.O = BIG + (size_t)16 * MiB; E.ldc = D; }
                } else if (is_gemm_up) {
                    g = pg8::Gemm{H, (const bf16*)(ws + WS_WT_UP), M, FF2, D}; E.O = BIG; E.ldc = FF2;
                } else {
                    g = pg8::Gemm{ACT, (const bf16*)(ws + WS_WT_DOWN), M, D, FF}; E.O = BIG; E.ldc = D;
                }
                pg8::StaticOrder S; S.init(g.M, g.N, F.G, (int)blockIdx.x);
                pg8::gemm_phase<pg8::EpiBf16S, pg8::StaticOrder, true, true>(F.lds + RING_OFF, g, S, E);
            }
        }

        if (ph + 1 < args.ph_hi) { if (MK_N_LAUNCHES == 1) xcd_barrier(bar); }
    }
}

extern "C" void kernel_launch(void* const* d_in, const int* in_sizes, int n_in, void* d_out, int out_size, void* d_ws, size_t ws_size, hipStream_t stream) {
    static int grid = 0;
    if (grid == 0) {
        if (n_in != 19 || in_sizes[0] != M * D || out_size != M * D || ws_size < WS_END) { fprintf(stderr, "kernel_launch: unexpected problem (n_in %d, in0 %d, out %d, ws %zu); nothing launched\n", n_in, n_in > 0 ? in_sizes[0] : -1, out_size, ws_size); grid = -1; return; }
        int dev = 0, cus = 0;
        if (hipGetDevice(&dev) != hipSuccess || hipDeviceGetAttribute(&cus, hipDeviceAttributeMultiprocessorCount, dev) != hipSuccess) { grid = -1; return; }
        if (hipFuncSetAttribute((const void*)yoco_fwd, hipFuncAttributeMaxDynamicSharedMemorySize, LDS_BYTES) != hipSuccess) { fprintf(stderr, "kernel_launch: hipFuncSetAttribute failed\n"); grid = -1; return; }
        int per_cu = 0;
        if (hipOccupancyMaxActiveBlocksPerMultiprocessor(&per_cu, (const void*)yoco_fwd, NWAVES * 64, LDS_BYTES) != hipSuccess || per_cu < 1) fprintf(stderr, "kernel_launch: note: occupancy query reports %d workgroups per CU\n", per_cu);
        (void)hipGetLastError();
        grid = cus;
    }
    if (grid < 0) return;
    if (hipMemsetAsync((char*)d_ws + WS_CTL, 0, CTL_ZERO_BYTES, stream) != hipSuccess) return;
    Args a{};
    for (int i = 0; i < 19; ++i) a.in[i] = (const float*)d_in[i];
    a.out = (float*)d_out; a.ws = (unsigned char*)d_ws;
    if (MK_N_LAUNCHES == 1) {
        a.ph_lo = 0; a.ph_hi = N_PHASES;
        hipLaunchKernelGGL(yoco_fwd, dim3(grid), dim3(NWAVES * 64), LDS_BYTES, stream, a);
    } else {
        for (int ph = 0; ph < N_PHASES; ++ph) { a.ph_lo = ph; a.ph_hi = ph + 1; hipLaunchKernelGGL(yoco_fwd, dim3(grid), dim3(NWAVES * 64), LDS_BYTES, stream, a); }
    }
}
```

```cpp
#include <hip/hip_runtime.h>
#include <cstdio>
#include <cstdint>

#ifndef MK_N_LAUNCHES
#define MK_N_LAUNCHES 1
#endif
#ifndef NAIVE_P1
#define NAIVE_P1 0
#endif
#ifndef NAIVE_P2
#define NAIVE_P2 0
#endif
#ifndef NAIVE_ATT
#define NAIVE_ATT 0
#endif

constexpr int BATCH = 2, SEQ = 8192, D = 1024, M = BATCH * SEQ, DEPTH = 4;
constexpr int RH = 4, RDK = 256, RDV = 512, RC = 128, NCH = SEQ / RC;
constexpr int RETN = 6144, FF = 2816, FF2 = 5632;
constexpr int SHEADS = 16, SKVH = 4, SHD = 64, WIN = 128;
constexpr float NORM_EPS = 1e-6f;

namespace pg8 {
#define PG8_LAS __attribute__((address_space(3)))
typedef unsigned short bf16_t;
typedef short bf16x8 __attribute__((ext_vector_type(8)));
typedef float f32x4 __attribute__((ext_vector_type(4)));
typedef unsigned u32x4 __attribute__((ext_vector_type(4)));
constexpr int BM = 256, BK = 64, HALF = 128, HTB = HALF * BK * 2  , STAGE_BYTES = 8 * HTB, NXCD = 8, WGM = 8;

__host__ __device__ __forceinline__ int lds_byte(int r, int c) { const int st = (r >> 4) * 2 + (c >> 5), rr = r & 15, cc = c & 31, ob = rr * 64 + cc * 2; return st * 1024 + (ob ^ (((ob >> 9) & 1) << 5)); }
__host__ __device__ __forceinline__ void stage_rc(int b, int& R, int& C) { const int st = b / 1024, sb = b % 1024, swz = sb ^ (((sb >> 9) & 1) << 5); R = (st >> 1) * 16 + swz / 64; C = (st & 1) * 32 + (swz % 64) / 2; }
__host__ __device__ __forceinline__ int perm32(int rho) { const int n = rho >> 4, i = rho & 15; return 8 * (i >> 2) + 4 * n + (i & 3); }

struct Unit { int pm, pn; };
struct Gemm { const bf16_t* A; const bf16_t* Bt; int M, N, K; };

struct StaticOrder {
    int nM, nN, nwg, G, c;
    __host__ __device__ void init(int M, int N, int G_, int c_) { nM = M / BM; nN = N / BM; nwg = nM * nN; G = G_; c = c_; }
    __host__ __device__ bool next(int i, Unit& u) const {
        const long L = (long)i * G + c; if (L >= nwg) return false;
        int wgid = (int)L; { const int q = nwg / NXCD, r = nwg % NXCD, xcd = wgid % NXCD, off = wgid / NXCD; wgid = (xcd < r ? xcd * (q + 1) : r * (q + 1) + (xcd - r) * q) + off; }
        const int nig = WGM * nN, gid = wgid / nig, fm = gid * WGM, gsz = (nM - fm) < WGM ? (nM - fm) : WGM;
        u.pm = fm + ((wgid % nig) % gsz); u.pn = (wgid % nig) / gsz; return true;
    }
    __device__ __forceinline__ void a_ready(const Unit&) const {}
    __device__ __forceinline__ void done(const Unit&) const {}
};
__device__ __forceinline__ unsigned cvt_pk_bf16(float lo, float hi) { unsigned r; asm volatile("v_cvt_pk_bf16_f32 %0, %1, %2" : "=v"(r) : "v"(lo), "v"(hi)); return r; }
typedef float f32x2 __attribute__((ext_vector_type(2)));
__device__ __forceinline__ float silu_f(float x) { return x * __builtin_amdgcn_rcpf(1.0f + __expf(-x)); }
__device__ __forceinline__ u32x4 pack8(const f32x4 v0, const f32x4 v1) { u32x4 w; w.x = cvt_pk_bf16(v0[0], v0[1]); w.y = cvt_pk_bf16(v0[2], v0[3]); w.z = cvt_pk_bf16(v1[0], v1[1]); w.w = cvt_pk_bf16(v1[2], v1[3]); return w; }

struct EpiBf16S {
    static constexpr bool PERM = true, AFTER_DRAIN = false;
    bf16_t* O; int ldc; int split_cols; size_t split_stride; float scale;
    __device__ __forceinline__ void operator()(const f32x4 (&acc)[2][2][4][2], const Unit& u, int wr, int wc, int fr, int fq) const {
        const int row0 = u.pm * BM + wr * 64 + fr; int colt = u.pn * BM; bf16_t* base = O;
        if (split_cols) { const int t = colt / split_cols; base += (size_t)t * split_stride; colt -= t * split_cols; }
        const int col0 = colt + wc * 32 + 8 * fq;
#pragma unroll
        for (int ai = 0; ai < 2; ++ai)
#pragma unroll
            for (int m = 0; m < 4; ++m) { bf16_t* rowp = base + (size_t)(row0 + ai * HALF + m * 16) * ldc + col0;
#pragma unroll
                for (int bj = 0; bj < 2; ++bj) *(u32x4*)(rowp + bj * HALF) = pack8(acc[ai][bj][m][0] * scale, acc[ai][bj][m][1] * scale); }
    }
};

struct EpiRetQKG {
    static constexpr bool PERM = true, AFTER_DRAIN = false;
    bf16_t* QT; bf16_t* KT; bf16_t* G; const float* cosT; const float* sinT; const float* scq; const float* sck;
    __device__ __forceinline__ void operator()(const f32x4 (&acc)[2][2][4][2], const Unit& u, int wr, int wc, int fr, int fq) const {
        const int row0 = u.pm * BM + wr * 64 + fr;
        if (u.pn < 8) {
            const int head = u.pn & 3; const bool isk = u.pn >= 4;
            bf16_t* dst = (isk ? KT : QT) + head * 256;
            const float* sct = (isk ? sck : scq) + head * 128;
            const int ci = wc * 32 + 8 * fq;
#pragma unroll
            for (int ai = 0; ai < 2; ++ai)
#pragma unroll
                for (int m = 0; m < 4; ++m) {
                    const int row = row0 + ai * HALF + m * 16, pos = row & (SEQ - 1);
                    const float s = sct[pos & 127];
                    const f32x4 c0 = *(const f32x4*)(cosT + (size_t)pos * 128 + ci), c1 = *(const f32x4*)(cosT + (size_t)pos * 128 + ci + 4);
                    const f32x4 s0 = *(const f32x4*)(sinT + (size_t)pos * 128 + ci), s1 = *(const f32x4*)(sinT + (size_t)pos * 128 + ci + 4);
                    const f32x4 a0 = acc[ai][0][m][0], a1 = acc[ai][0][m][1], b0 = acc[ai][1][m][0], b1 = acc[ai][1][m][1];
                    const f32x4 o10 = (a0 * c0 - b0 * s0) * s, o11 = (a1 * c1 - b1 * s1) * s, o20 = (b0 * c0 + a0 * s0) * s, o21 = (b1 * c1 + a1 * s1) * s;
                    bf16_t* rowp = dst + (size_t)row * 1024 + ci;
                    *(u32x4*)(rowp) = pack8(o10, o11); *(u32x4*)(rowp + 128) = pack8(o20, o21);
                }
        } else {
            const int col0 = (u.pn - 8) * BM + wc * 32 + 8 * fq;
#pragma unroll
            for (int ai = 0; ai < 2; ++ai)
#pragma unroll
                for (int m = 0; m < 4; ++m) { bf16_t* rowp = G + (size_t)(row0 + ai * HALF + m * 16) * 2048 + col0;
#pragma unroll
                    for (int bj = 0; bj < 2; ++bj) { f32x4 v0 = acc[ai][bj][m][0], v1 = acc[ai][bj][m][1];
#pragma unroll
                        for (int e = 0; e < 4; ++e) { v0[e] = silu_f(v0[e]); v1[e] = silu_f(v1[e]); }
                        *(u32x4*)(rowp + bj * HALF) = pack8(v0, v1); } }
        }
    }
};

struct EpiVT {
    static constexpr bool PERM = true, AFTER_DRAIN = false;
    bf16_t* VT; int mode;
    __device__ __forceinline__ void operator()(const f32x4 (&acc)[2][2][4][2], const Unit& u, int wr, int wc, int fr, int fq) const {
        const int ch0 = u.pm * BM + wr * 64 + fr, tok0 = u.pn * BM + wc * 32 + 8 * fq;
#pragma unroll
        for (int ai = 0; ai < 2; ++ai)
#pragma unroll
            for (int m = 0; m < 4; ++m) { const int ch = ch0 + ai * HALF + m * 16, h = ch >> 9, dv = ch & 511;
#pragma unroll
                for (int bj = 0; bj < 2; ++bj) { const int tok = tok0 + bj * HALF, b = tok >> 13, sp = tok & (SEQ - 1), chunk = sp >> 7, j = sp & 127;
                    bf16_t* p = mode == 0 ? VT + ((((size_t)(b * 4 + h) * 64 + chunk) * 512 + dv) * 128 + j) : VT + ((size_t)(b * 256 + ch) * SEQ + sp);
                    *(u32x4*)p = pack8(acc[ai][bj][m][0], acc[ai][bj][m][1]); } }
    }
};

template <class Epi, class Sched, bool ALIGN_EPI = false, bool SP2 = false>
__device__ __forceinline__ void gemm_phase(PG8_LAS unsigned char* lds, const Gemm g, const Sched& S, const Epi& E) {
    const int tid = threadIdx.x, wid = __builtin_amdgcn_readfirstlane(tid >> 6), lane = tid & 63, wr = wid >> 2, wc = wid & 3, fr = lane & 15, fq = lane >> 4;
    const int K = g.K, nt = K / BK;
    unsigned voffA[2], voffB[2];
#pragma unroll
    for (int i = 0; i < 2; ++i) { int R, C; stage_rc(tid * 16 + i * 8192, R, C); const int Rb = Epi::PERM ? ((R & ~31) + perm32(R & 31)) : R;
        voffA[i] = (unsigned)(R * K + C) * 2u; voffB[i] = (unsigned)(Rb * K + C) * 2u; }
    const size_t kstep = (size_t)(BK * 2);
    const size_t hstep = (size_t)HALF * K * 2;
    const size_t tstep = 2 * hstep;
    const unsigned ldsw = (unsigned)wid * 1024u;
    const int aoff = lds_byte(wr * 64 + fr, fq * 8), boff = lds_byte(wc * 32 + fr, fq * 8);
#define PG8_SA(b, h) (((b) * 2 + (h)) * HTB)
#define PG8_SB(b, h) ((4 + (b) * 2 + (h)) * HTB)
#define PG8_STAGE(bufoff, gbase, voff) do { _Pragma("unroll") for (int _i = 0; _i < 2; ++_i) \
        __builtin_amdgcn_global_load_lds((const unsigned*)((const char*)(gbase) + (voff)[_i]), (PG8_LAS unsigned*)(lds + (bufoff) + ldsw + _i * 8192), 16, 0, 0); } while (0)
#define PG8_LDA(dst, b, h) do { _Pragma("unroll") for (int m = 0; m < 4; ++m) _Pragma("unroll") for (int k = 0; k < 2; ++k) dst[m][k] = *(const PG8_LAS bf16x8*)(lds + PG8_SA(b, h) + aoff + m * 2048 + k * 1024); } while (0)
#define PG8_LDB(dst, b, h) do { _Pragma("unroll") for (int n = 0; n < 2; ++n) _Pragma("unroll") for (int k = 0; k < 2; ++k) dst[n][k] = *(const PG8_LAS bf16x8*)(lds + PG8_SB(b, h) + boff + n * 2048 + k * 1024); } while (0)
#define PG8_MMA(ai, bj, At, Bt) do { __builtin_amdgcn_s_setprio(1); _Pragma("unroll") for (int m = 0; m < 4; ++m) _Pragma("unroll") for (int n = 0; n < 2; ++n) _Pragma("unroll") for (int k = 0; k < 2; ++k) \
        acc[ai][bj][m][n] = __builtin_amdgcn_mfma_f32_16x16x32_bf16(Bt[n][k], At[m][k], acc[ai][bj][m][n], 0, 0, 0); __builtin_amdgcn_s_setprio(0); } while (0)
#define PG8_WAIT_V(n) asm volatile("s_waitcnt vmcnt(" #n ")" ::: "memory")
#define PG8_WAIT_L(n) asm volatile("s_waitcnt lgkmcnt(" #n ")" ::: "memory")
#define PG8_BAR __builtin_amdgcn_s_barrier()
#define PG8_SCHED __builtin_amdgcn_sched_barrier(0)
    Unit cur, nxt; int ui = 0;
    if (!S.next(0, cur)) return;
    f32x4 acc[2][2][4][2];
#pragma unroll
    for (int a = 0; a < 2; ++a)
#pragma unroll
        for (int b = 0; b < 2; ++b)
#pragma unroll
            for (int m = 0; m < 4; ++m)
#pragma unroll
                for (int n = 0; n < 2; ++n) acc[a][b][m][n] = (f32x4){0.f, 0.f, 0.f, 0.f};
    bf16x8 At[4][2], B0[2][2], B1[2][2];
    const char* cA = (const char*)g.A + (size_t)cur.pm * tstep; const char* cB = (const char*)g.Bt + (size_t)cur.pn * tstep;
    S.a_ready(cur);
    if constexpr (SP2) {
        PG8_STAGE(PG8_SB(0, 0), cB, voffB); PG8_STAGE(PG8_SB(0, 1), cB + hstep, voffB); PG8_STAGE(PG8_SA(0, 0), cA, voffA); PG8_STAGE(PG8_SA(0, 1), cA + hstep, voffA);
        if (wr == 1) PG8_BAR;
        PG8_WAIT_V(2); PG8_BAR;
        PG8_STAGE(PG8_SB(1, 0), cB + kstep, voffB); PG8_STAGE(PG8_SA(1, 0), cA + kstep, voffA); PG8_STAGE(PG8_SB(1, 1), cB + hstep + kstep, voffB);
        PG8_WAIT_V(6); PG8_BAR;
    } else {
        PG8_STAGE(PG8_SB(0, 0), cB, voffB); PG8_STAGE(PG8_SA(0, 0), cA, voffA); PG8_STAGE(PG8_SB(0, 1), cB + hstep, voffB); PG8_STAGE(PG8_SA(0, 1), cA + hstep, voffA);
        if (wr == 1) PG8_BAR;
        PG8_WAIT_V(4); PG8_BAR;
        PG8_STAGE(PG8_SB(1, 0), cB + kstep, voffB); PG8_STAGE(PG8_SA(1, 0), cA + kstep, voffA); PG8_STAGE(PG8_SB(1, 1), cB + hstep + kstep, voffB);
        PG8_WAIT_V(6); PG8_BAR;
    }
    for (;;) {
        const bool has_next = S.next(ui + 1, nxt);
        const char* nA = has_next ? (const char*)g.A + (size_t)nxt.pm * tstep : cA; const char* nB = has_next ? (const char*)g.Bt + (size_t)nxt.pn * tstep : cB;
        for (int t = 0; t < nt; t += 2) {
            const bool last = (t == nt - 2);
            const char* a1 = cA + (size_t)(t + 1) * kstep;
            const char* a2 = last ? nA : cA + (size_t)(t + 2) * kstep; const char* b2 = last ? nB : cB + (size_t)(t + 2) * kstep;
            const char* a3 = a2 + kstep; const char* b3 = b2 + kstep;
            if (last && has_next) S.a_ready(nxt);
            if constexpr (SP2) {
            PG8_LDB(B0, 0, 0); PG8_LDB(B1, 0, 1); PG8_SCHED; PG8_LDA(At, 0, 0); PG8_STAGE(PG8_SA(1, 1), a1 + hstep, voffA);
            PG8_WAIT_V(8); PG8_WAIT_L(0); PG8_BAR; PG8_MMA(0, 0, At, B0); PG8_MMA(0, 1, At, B1); PG8_BAR; PG8_SCHED;
            PG8_LDA(At, 0, 1); PG8_STAGE(PG8_SB(0, 0), b2, voffB); PG8_STAGE(PG8_SB(0, 1), b2 + hstep, voffB); PG8_STAGE(PG8_SA(0, 0), a2, voffA);
            PG8_WAIT_V(8); PG8_WAIT_L(0); PG8_BAR; PG8_MMA(1, 0, At, B0); PG8_MMA(1, 1, At, B1); PG8_BAR; PG8_SCHED;
            PG8_LDB(B0, 1, 0); PG8_LDB(B1, 1, 1); PG8_SCHED; PG8_LDA(At, 1, 0); PG8_STAGE(PG8_SA(0, 1), a2 + hstep, voffA);
            PG8_WAIT_V(8); PG8_WAIT_L(0); PG8_BAR; PG8_MMA(0, 0, At, B0); PG8_MMA(0, 1, At, B1); PG8_BAR; PG8_SCHED;
            PG8_LDA(At, 1, 1); PG8_STAGE(PG8_SB(1, 0), b3, voffB); PG8_STAGE(PG8_SB(1, 1), b3 + hstep, voffB); PG8_STAGE(PG8_SA(1, 0), a3, voffA);
            PG8_WAIT_V(8); PG8_WAIT_L(0); PG8_BAR; PG8_MMA(1, 0, At, B0); PG8_MMA(1, 1, At, B1); PG8_BAR; PG8_SCHED;
            } else {
            PG8_LDB(B0, 0, 0); PG8_SCHED; PG8_LDA(At, 0, 0); PG8_STAGE(PG8_SA(1, 1), a1 + hstep, voffA);
            PG8_WAIT_L(8); PG8_BAR; PG8_WAIT_L(0); PG8_MMA(0, 0, At, B0); PG8_BAR; PG8_SCHED;
            PG8_LDB(B1, 0, 1); PG8_STAGE(PG8_SB(0, 0), b2, voffB);
            PG8_BAR; PG8_WAIT_L(0); PG8_MMA(0, 1, At, B1); PG8_BAR;
            PG8_LDA(At, 0, 1); PG8_STAGE(PG8_SA(0, 0), a2, voffA);
            PG8_BAR; PG8_WAIT_L(0); PG8_MMA(1, 0, At, B0); PG8_BAR; PG8_SCHED;
            PG8_STAGE(PG8_SB(0, 1), b2 + hstep, voffB);
            PG8_WAIT_V(6); PG8_BAR; PG8_MMA(1, 1, At, B1); PG8_BAR;
            PG8_LDB(B0, 1, 0); PG8_SCHED; PG8_LDA(At, 1, 0); PG8_STAGE(PG8_SA(0, 1), a2 + hstep, voffA);
            PG8_WAIT_L(8); PG8_BAR; PG8_WAIT_L(0); PG8_MMA(0, 0, At, B0); PG8_BAR; PG8_SCHED;
            PG8_LDB(B1, 1, 1); PG8_STAGE(PG8_SB(1, 0), b3, voffB);
            PG8_BAR; PG8_WAIT_L(0); PG8_MMA(0, 1, At, B1); PG8_BAR;
            PG8_LDA(At, 1, 1); PG8_STAGE(PG8_SA(1, 0), a3, voffA);
            PG8_BAR; PG8_WAIT_L(0); PG8_MMA(1, 0, At, B0); PG8_BAR; PG8_SCHED;
            PG8_STAGE(PG8_SB(1, 1), b3 + hstep, voffB);
            PG8_WAIT_V(6); PG8_BAR; PG8_MMA(1, 1, At, B1); PG8_BAR;
            }
        }
        if constexpr (ALIGN_EPI) { if (wr == 0) PG8_BAR; }
        if constexpr (!Epi::AFTER_DRAIN) { E(acc, cur, wr, wc, fr, fq); S.done(cur); }
        if (!has_next) break;
#pragma unroll
        for (int a = 0; a < 2; ++a)
#pragma unroll
            for (int b = 0; b < 2; ++b)
#pragma unroll
                for (int m = 0; m < 4; ++m)
#pragma unroll
                    for (int n = 0; n < 2; ++n) acc[a][b][m][n] = (f32x4){0.f, 0.f, 0.f, 0.f};
        cur = nxt; cA = nA; cB = nB; ++ui;
        if constexpr (ALIGN_EPI) { if (wr == 1) PG8_BAR; }
    }
    PG8_WAIT_V(0);
    if constexpr (!ALIGN_EPI) { if (wr == 0) PG8_BAR; }
    PG8_BAR;
    if constexpr (Epi::AFTER_DRAIN) { E.fused(acc, cur, wr, wc, fr, fq, lds, wid, lane); S.done(cur); }
#undef PG8_SA
#undef PG8_SB
#undef PG8_STAGE
#undef PG8_LDA
#undef PG8_LDB
#undef PG8_MMA
#undef PG8_WAIT_V
#undef PG8_WAIT_L
#undef PG8_BAR
#undef PG8_SCHED
}
}

#define GAS __attribute__((address_space(1)))
#define LAS __attribute__((address_space(3)))
typedef unsigned short bf16;
typedef unsigned v4u __attribute__((ext_vector_type(4)));
typedef float f32x4 __attribute__((ext_vector_type(4)));
typedef short bf16x8 __attribute__((ext_vector_type(8)));
typedef GAS unsigned gu32;
typedef GAS unsigned long long gu64;
#define RLX_AGENT __ATOMIC_RELAXED, __HIP_MEMORY_SCOPE_AGENT
#define LDS_WAIT() asm volatile("s_waitcnt lgkmcnt(0)" ::: "memory")
#define VM_WAIT() asm volatile("s_waitcnt vmcnt(0)" ::: "memory")
__device__ __forceinline__ unsigned long long rt() { return __builtin_amdgcn_s_memrealtime(); }
__device__ __forceinline__ unsigned f2bf(float f) { unsigned u = __builtin_bit_cast(unsigned, f); return (u + 0x7fffu + ((u >> 16) & 1u)) >> 16; }
__device__ __forceinline__ unsigned pk2(float lo, float hi) { return f2bf(lo) | (f2bf(hi) << 16); }
#define XB_TMO      128
#define XB_XCNT(j)  (256  + 64 * (j))
#define XB_XSUB(j)  (1280 + 64 * (j))
#define XB_XGEN(j)  (2304 + 64 * (j))
#define XB_TOP      3328
#define XB_TOPGEN   3392
#define XCD_BAR_WORDS 3456
#define XB_SPIN_CAP (1u << 18)

__device__ __forceinline__ unsigned xb_ld(unsigned* p)              { return __hip_atomic_load(p, __ATOMIC_RELAXED, __HIP_MEMORY_SCOPE_AGENT); }
__device__ __forceinline__ unsigned xb_add(unsigned* p, unsigned v) { return __hip_atomic_fetch_add(p, v, __ATOMIC_RELAXED, __HIP_MEMORY_SCOPE_AGENT); }
__device__ __forceinline__ unsigned xb_xcc_id() { return (unsigned)__builtin_amdgcn_s_getreg((3 << 11) | 20) & 0xFu; }
#define XB_SPIN(cond, bar) do { unsigned _sp = 0; while (cond) { __builtin_amdgcn_s_sleep(1); \
    if ((++_sp & 255u) == 0u) { if (xb_ld(&(bar)[XB_TMO])) break; if (_sp > XB_SPIN_CAP) { atomicAdd(&(bar)[XB_TMO], 1u); break; } } } } while (0)

struct XcdBarrier {
    unsigned* bar; unsigned x;
    volatile LAS unsigned* st;
};

__device__ __forceinline__ XcdBarrier xcd_barrier_post(unsigned* bar, volatile LAS unsigned* st) {
    XcdBarrier b; b.bar = bar; b.x = xb_xcc_id(); b.st = st;
    if (threadIdx.x == 0) (void)xb_add(&bar[XB_XCNT(b.x)], 1u);
    return b;
}
__device__ __forceinline__ void xcd_barrier_complete(unsigned* bar, unsigned x, unsigned& nloc, unsigned& nx) {
    const unsigned G = gridDim.x * gridDim.y * gridDim.z;
    unsigned sum, cnt, mine, sp = 0u;
    for (;;) {
        sum = 0u; cnt = 0u; mine = 0u;
#pragma unroll
        for (unsigned j = 0; j < 16; ++j) { const unsigned c = xb_ld(&bar[XB_XCNT(j)]); sum += c; cnt += (c > 0u) ? 1u : 0u; mine = (j == x) ? c : mine; }
        if (sum == G) break;
        __builtin_amdgcn_s_sleep(1);
        if ((++sp & 255u) == 0u) { if (xb_ld(&bar[XB_TMO])) break; if (sp > XB_SPIN_CAP) { atomicAdd(&bar[XB_TMO], 1u); break; } }
    }
    nloc = mine > 0u ? mine : 1u; nx = cnt > 0u ? cnt : 1u;
}

__device__ __forceinline__ void xcd_barrier(const XcdBarrier& b) {
    asm volatile("s_waitcnt vmcnt(0)" ::: "memory");
    __syncthreads();
    if (threadIdx.x == 0) {
        unsigned* bar = b.bar;
        __builtin_amdgcn_s_waitcnt(0);
        unsigned nloc = b.st[0], nx = b.st[1];
        if (nloc == 0u) { xcd_barrier_complete(bar, b.x, nloc, nx); b.st[0] = nloc; b.st[1] = nx; }
        const unsigned old = xb_add(&bar[XB_XSUB(b.x)], 1u);
        const unsigned gen = old / nloc;
        if (old + 1u == (gen + 1u) * nloc) {
            __builtin_amdgcn_fence(__ATOMIC_RELEASE, "agent");
            asm volatile("s_waitcnt vmcnt(0)" ::: "memory");
            const unsigned og = xb_add(&bar[XB_TOP], 1u);
            const unsigned tg = og / nx;
            if (og + 1u == (tg + 1u) * nx) xb_add(&bar[XB_TOPGEN], 1u);
            else XB_SPIN(xb_ld(&bar[XB_TOPGEN]) == tg, bar);
            __builtin_amdgcn_fence(__ATOMIC_ACQUIRE, "agent");
            xb_add(&bar[XB_XGEN(b.x)], 1u);
            asm volatile("s_waitcnt vmcnt(0)" ::: "memory");
        } else {
            XB_SPIN(xb_ld(&bar[XB_XGEN(b.x)]) == gen, bar);
            __builtin_amdgcn_fence(__ATOMIC_ACQUIRE, "agent");
            asm volatile("s_waitcnt vmcnt(0)" ::: "memory");
        }
    }
    __syncthreads();
}

constexpr size_t MiB = 1u << 20;
constexpr size_t WS_CTL = 0, CTL_ZERO_BYTES = 1 * MiB;
constexpr size_t WS_COS = 1 * MiB, WS_SIN = 5 * MiB;
constexpr size_t WS_MODS = 9 * MiB;
constexpr size_t WS_KVMOD = 9 * MiB + 256 * 1024;
constexpr size_t WS_SCQ = 9 * MiB + 320 * 1024, WS_SCK = WS_SCQ + 4096, WS_SCG = WS_SCQ + 8192;
constexpr size_t WS_BIAS = 9 * MiB + 384 * 1024;
constexpr size_t WS_WT_IN = 10 * MiB, WS_WT_OUT = 22 * MiB, WS_WT_UP = 26 * MiB, WS_WT_DOWN = 37 * MiB, WS_WT_KV = 43 * MiB;
constexpr size_t WS_KSH = 44 * MiB, WS_VSH = 52 * MiB;
constexpr size_t WS_R = 60 * MiB;
constexpr size_t WS_BIG = 188 * MiB;
constexpr size_t WS_END = 380 * MiB;
constexpr int CW_TMO = 0, CW_BAR = 4096;

constexpr int RING_OFF = 0, RING_BYTES = 131072;
constexpr int LDSCTL_OFF = RING_BYTES, MISC_OFF = LDSCTL_OFF + 320;
constexpr int LDS_BYTES = 147456;
constexpr int NWAVES = 8;

__constant__ unsigned char T5_BUCKET[128] = {0, 1, 2, 3, 4, 5, 6, 7, 8, 9, 10, 11, 12, 13, 14, 15, 16, 16, 16, 17, 17, 18, 18, 18, 19, 19, 19, 20, 20, 20, 20, 21, 21, 21, 21, 22, 22, 22, 22, 22, 23, 23, 23, 23, 23, 23, 24, 24, 24, 24, 24, 24, 25, 25, 25, 25, 25, 25, 25, 26, 26, 26, 26, 26, 26, 26, 26, 27, 27, 27, 27, 27, 27, 27, 27, 27, 27, 28, 28, 28, 28, 28, 28, 28, 28, 28, 28, 29, 29, 29, 29, 29, 29, 29, 29, 29, 29, 29, 29, 30, 30, 30, 30, 30, 30, 30, 30, 30, 30, 30, 30, 30, 30, 31, 31, 31, 31, 31, 31, 31, 31, 31, 31, 31, 31, 31, 31, 31};

struct Frame {
    LAS unsigned char* lds;
    volatile LAS unsigned* MISC;
    gu32* ctl;
    int tid, lane, wave, vcu, G;
    unsigned char* ws;
    const float* __attribute__((address_space(4)))* in;
    float* out;
};
enum { I_X = 0, I_C, I_NORMG, I_ADAW, I_ADAB, I_RWIN, I_RWOUT, I_KVNG, I_KVADAW, I_KVADAB, I_KVW, I_SWQ, I_SWO, I_SINKS, I_RELB, I_WUP, I_CONVW, I_CONVB, I_WDOWN };

__device__ __forceinline__ float bf2f(bf16 h) { return __uint_as_float(((unsigned)h) << 16); }
__device__ __forceinline__ float wave_sum(float v) {
#pragma unroll
    for (int o = 1; o < 64; o <<= 1) v += __shfl_xor(v, o);
    return v;
}
__device__ __forceinline__ float wave_max(float v) {
#pragma unroll
    for (int o = 1; o < 64; o <<= 1) v = fmaxf(v, __shfl_xor(v, o));
    return v;
}
__device__ __forceinline__ float dot8(const v4u a, const v4u b) {
    float s = 0.f;
#pragma unroll
    for (int e = 0; e < 4; ++e) { s += __uint_as_float(a[e] << 16) * __uint_as_float(b[e] << 16); s += __uint_as_float(a[e] & 0xffff0000u) * __uint_as_float(b[e] & 0xffff0000u); }
    return s;
}
__device__ __forceinline__ float silu(float x) { return x * __builtin_amdgcn_rcpf(1.0f + __expf(-x)); }

__device__ __forceinline__ void phase_mods(Frame& F) {
    LAS float* cact = (LAS float*)(F.lds);
    LAS float* part = (LAS float*)(F.lds + 8192);
    for (int i = F.tid; i < 2 * D; i += 512) cact[i] = silu(F.in[I_C][i]);
    __syncthreads();
    const int item = F.vcu;
    const float* W = nullptr; const float* bias = nullptr; float* outp = nullptr; int N = 0, ostride = 0;
    if (item < 208) {
        const int col0 = item * 128;
        if (col0 < 4 * 6144) { const int l = col0 / 6144, cl = col0 % 6144; W = F.in[I_ADAW] + (size_t)l * D * 6144 + cl; N = 6144; bias = F.in[I_ADAB] + l * 6144 + cl; outp = (float*)(F.ws + WS_MODS) + l * 2 * 6144 + cl; ostride = 6144; }
        else { const int cl = col0 - 4 * 6144; W = F.in[I_KVADAW] + cl; N = 2048; bias = F.in[I_KVADAB] + cl; outp = (float*)(F.ws + WS_KVMOD) + cl; ostride = 2048; }
        const int cg = F.wave & 1, kq = F.wave >> 1, col = 64 * cg + F.lane, k0 = kq * 256;
        float a0 = 0.f, a1 = 0.f;
#pragma unroll 8
        for (int k = k0; k < k0 + 256; ++k) { const float w = W[(size_t)k * N + col]; a0 += w * cact[k]; a1 += w * cact[D + k]; }
        part[(F.wave * 2 + 0) * 64 + F.lane] = a0; part[(F.wave * 2 + 1) * 64 + F.lane] = a1;
    }
    __syncthreads();
    if (item < 208 && F.tid < 256) {
        const int b = F.tid >> 7, col = F.tid & 127, cg = col >> 6, ln = col & 63; float s = 0.f;
#pragma unroll
        for (int kq = 0; kq < 4; ++kq) s += part[(((kq << 1) | cg) * 2 + b) * 64 + ln];
        outp[b * ostride + col] = s + bias[col];
    }
    __syncthreads();
}
__device__ __forceinline__ void sincos_d(double a, double& s, double& c) {
    const double k = __builtin_rint(a * 0.6366197723675814);
    double r = __builtin_fma(-k, 1.5707963267948966, a); r = __builtin_fma(-k, 6.123233995736766e-17, r);
    const double r2 = r * r;
    double sp = 1.0 / 6227020800.0; sp = sp * r2 - 1.0 / 39916800.0; sp = sp * r2 + 1.0 / 362880.0; sp = sp * r2 - 1.0 / 5040.0; sp = sp * r2 + 1.0 / 120.0; sp = sp * r2 - 1.0 / 6.0; sp = r + r * r2 * sp;
    double cp = -1.0 / 87178291200.0; cp = cp * r2 + 1.0 / 479001600.0; cp = cp * r2 - 1.0 / 3628800.0; cp = cp * r2 + 1.0 / 40320.0; cp = cp * r2 - 1.0 / 720.0; cp = cp * r2 + 1.0 / 24.0; cp = cp * r2 - 0.5; cp = 1.0 + r2 * cp;
    const int q = ((int)k) & 3;
    s = (q == 0) ? sp : (q == 1) ? cp : (q == 2) ? -sp : -cp;
    c = (q == 0) ? cp : (q == 1) ? -sp : (q == 2) ? -cp : sp;
}
__device__ __forceinline__ void phase_tables(Frame& F) {
    float* cosT = (float*)(F.ws + WS_COS); float* sinT = (float*)(F.ws + WS_SIN);
    const int NT = F.G * 512;
    for (int idx = F.vcu * 512 + F.tid; idx < SEQ * 128; idx += NT) {
        const int pos = idx >> 7, i = idx & 127;
        double inv = 1.0, r = 0.930572040929699;
#pragma unroll
        for (int bit = 0; bit < 7; ++bit) { if ((i >> bit) & 1) inv *= r; r *= r; }
        double s, c; sincos_d((double)pos * inv, s, c);
        cosT[idx] = (float)c; sinT[idx] = (float)s;
    }
    if (F.vcu == F.G - 1) {
        float* scq = (float*)(F.ws + WS_SCQ); float* sck = (float*)(F.ws + WS_SCK); float* scg = (float*)(F.ws + WS_SCG); float* bias = (float*)(F.ws + WS_BIAS);
        { const int h = F.tid >> 7, p = F.tid & 127; double gam = 1.0 - 1.0 / (double)(32 << h), g = 1.0;
          for (int e = 0; e <= p; ++e) g *= gam;
          scq[F.tid] = (float)g; sck[F.tid] = (float)(0.0625 / g);
          if (p == 127) scg[h] = (float)g; }
        for (int idx = F.tid; idx < 16 * 128; idx += 512) { const int head = idx >> 7, dist = idx & 127; bias[idx] = F.in[I_RELB][(int)T5_BUCKET[dist] * 16 + head]; }
    }
}
__device__ __forceinline__ void transpose_item(const float* W, int K, int N, bf16* WT, LAS float* scr, int item, int lane, int mode) {
    const int nblk = N / 32, kb = item / nblk, nb = item % nblk, k0 = 64 * kb, n0 = 32 * nb;
    int r0 = n0; if (mode == 1) r0 = n0 < 2048 ? n0 : (n0 < 4096 ? n0 + 2048 : n0 - 2048);
#pragma unroll 8
    for (int i = 0; i < 32; ++i) { const int kk = 2 * i + (lane >> 5); scr[kk * 33 + (lane & 31)] = W[(size_t)(k0 + kk) * N + n0 + (lane & 31)]; }
    LDS_WAIT(); asm volatile("" ::: "memory");
    const int c = lane & 7;
#pragma unroll
    for (int j = 0; j < 4; ++j) { const int n = (lane >> 3) + 8 * j; const LAS float* s = scr + (8 * c) * 33 + n;
        v4u o; o.x = pk2(s[0 * 33], s[1 * 33]); o.y = pk2(s[2 * 33], s[3 * 33]); o.z = pk2(s[4 * 33], s[5 * 33]); o.w = pk2(s[6 * 33], s[7 * 33]);
        *(GAS v4u*)(WT + (size_t)(r0 + n) * K + k0 + 8 * c) = o; }
    LDS_WAIT(); asm volatile("" ::: "memory");
}
__device__ __forceinline__ void phase_weights(Frame& F, int layer) {
    LAS float* scr = (LAS float*)(F.lds + RING_OFF + F.wave * 16384);
    const int gw = F.vcu * NWAVES + F.wave, NGW = F.G * NWAVES;
    const bool ret = layer < 2; const int li = ret ? layer : layer - 2;
    const float* w0 = ret ? F.in[I_RWIN] + (size_t)li * D * RETN : F.in[I_SWQ] + (size_t)li * D * D;        const int K0 = D, N0 = ret ? RETN : D;
    const float* w1 = ret ? F.in[I_RWOUT] + (size_t)li * 2048 * D : F.in[I_SWO] + (size_t)li * D * D;       const int K1 = ret ? 2048 : D, N1 = D;
    const float* w2 = F.in[I_WUP] + (size_t)layer * D * FF2;   const int K2 = D, N2 = FF2;
    const float* w3 = F.in[I_WDOWN] + (size_t)layer * FF * D;  const int K3 = FF, N3 = D;
    const int i0 = (K0 / 64) * (N0 / 32), i1 = (K1 / 64) * (N1 / 32), i2 = (K2 / 64) * (N2 / 32), i3 = (K3 / 64) * (N3 / 32), i4 = (layer == 2) ? (D / 64) * (512 / 32) : 0;
    const int total = i0 + i1 + i2 + i3 + i4;
    for (int it = gw; it < total; it += NGW) {
        int r = it;
        if (r < i0) { transpose_item(w0, K0, N0, (bf16*)(F.ws + WS_WT_IN), scr, r, F.lane, ret ? 1 : 0); continue; } r -= i0;
        if (r < i1) { transpose_item(w1, K1, N1, (bf16*)(F.ws + WS_WT_OUT), scr, r, F.lane, 0); continue; } r -= i1;
        if (r < i2) { transpose_item(w2, K2, N2, (bf16*)(F.ws + WS_WT_UP), scr, r, F.lane, 0); continue; } r -= i2;
        if (r < i3) { transpose_item(w3, K3, N3, (bf16*)(F.ws + WS_WT_DOWN), scr, r, F.lane, 0); continue; } r -= i3;
        transpose_item(F.in[I_KVW], D, 512, (bf16*)(F.ws + WS_WT_KV), scr, r, F.lane, 0);
    }
}

struct RowPass {
    const float* xsrc; float* xdst; const bf16* y; const float* gpost; const float* gate; int gstride;
    bf16* h1; const float* g1; const float* sc1; const float* sh1; int st1;
    bf16* h2; const float* g2; const float* sc2; const float* sh2; int st2;
};
__device__ __forceinline__ void phase_rowpass(Frame& F, const RowPass& P) {
    const int gw = F.vcu * NWAVES + F.wave, NGW = F.G * NWAVES;
    const int c0 = 4 * F.lane;
    for (int bb = 0; bb < BATCH; ++bb) {
        f32x4 cA[4], cB1[4], cC1[4], cB2[4], cC2[4];
#pragma unroll
        for (int j = 0; j < 4; ++j) {
            const int c = c0 + 256 * j;
            if (P.y) { const f32x4 g = *(const f32x4*)(P.gpost + c), t = *(const f32x4*)(P.gate + bb * P.gstride + c); cA[j] = g * (t + 1.0f); } else cA[j] = (f32x4){0.f, 0.f, 0.f, 0.f};
            if (P.h1) { const f32x4 g = *(const f32x4*)(P.g1 + c), s = *(const f32x4*)(P.sc1 + bb * P.st1 + c); cB1[j] = g * (s + 1.0f); cC1[j] = *(const f32x4*)(P.sh1 + bb * P.st1 + c); } else { cB1[j] = (f32x4){0.f, 0.f, 0.f, 0.f}; cC1[j] = cB1[j]; }
            if (P.h2) { const f32x4 g = *(const f32x4*)(P.g2 + c), s = *(const f32x4*)(P.sc2 + bb * P.st2 + c); cB2[j] = g * (s + 1.0f); cC2[j] = *(const f32x4*)(P.sh2 + bb * P.st2 + c); } else { cB2[j] = (f32x4){0.f, 0.f, 0.f, 0.f}; cC2[j] = cB2[j]; }
        }
        for (int m = bb * SEQ + gw; m < (bb + 1) * SEQ; m += NGW) {
            f32x4 x[4];
#pragma unroll
            for (int j = 0; j < 4; ++j) x[j] = *(const f32x4*)(P.xsrc + (size_t)m * D + c0 + 256 * j);
            if (P.y) {
                f32x4 yv[4]; float ss = 0.f;
#pragma unroll
                for (int j = 0; j < 4; ++j) { const uint2 w = *(const uint2*)(P.y + (size_t)m * D + c0 + 256 * j);
                    yv[j] = (f32x4){__uint_as_float(w.x << 16), __uint_as_float(w.x & 0xffff0000u), __uint_as_float(w.y << 16), __uint_as_float(w.y & 0xffff0000u)};
                    ss += (yv[j][0] * yv[j][0] + yv[j][1] * yv[j][1]) + (yv[j][2] * yv[j][2] + yv[j][3] * yv[j][3]); }
                const float rstd = __builtin_amdgcn_rsqf(wave_sum(ss) * (1.0f / D) + NORM_EPS);
#pragma unroll
                for (int j = 0; j < 4; ++j) x[j] = x[j] + cA[j] * yv[j] * rstd;
            }
            if (P.xdst) {
#pragma unroll
                for (int j = 0; j < 4; ++j) *(f32x4*)(P.xdst + (size_t)m * D + c0 + 256 * j) = x[j];
            }
            if (P.h1 || P.h2) {
                float ss = 0.f;
#pragma unroll
                for (int j = 0; j < 4; ++j) ss += (x[j][0] * x[j][0] + x[j][1] * x[j][1]) + (x[j][2] * x[j][2] + x[j][3] * x[j][3]);
                const float rstd = __builtin_amdgcn_rsqf(wave_sum(ss) * (1.0f / D) + NORM_EPS);
                if (P.h1) {
#pragma unroll
                    for (int j = 0; j < 4; ++j) { const f32x4 h = x[j] * rstd * cB1[j] + cC1[j]; uint2 w; w.x = pk2(h[0], h[1]); w.y = pk2(h[2], h[3]); *(uint2*)(P.h1 + (size_t)m * D + c0 + 256 * j) = w; }
                }
                if (P.h2) {
#pragma unroll
                    for (int j = 0; j < 4; ++j) { const f32x4 h = x[j] * rstd * cB2[j] + cC2[j]; uint2 w; w.x = pk2(h[0], h[1]); w.y = pk2(h[2], h[3]); *(uint2*)(P.h2 + (size_t)m * D + c0 + 256 * j) = w; }
                }
            }
        }
    }
}

__device__ __forceinline__ void phase_conv(Frame& F, int layer) {
    const bf16* U = (const bf16*)(F.ws + WS_BIG); bf16* A = (bf16*)(F.ws + WS_R);
    const float* cw = F.in[I_CONVW] + (size_t)layer * 3 * FF2; const float* cb = F.in[I_CONVB] + (size_t)layer * FF2;
    const int gw = F.vcu * NWAVES + F.wave, NGW = F.G * NWAVES;
    constexpr int NSEG = M / 16, NHT = NSEG * 11, NWT = NHT / 2;
    for (int wt = gw; wt < NWT; wt += NGW) {
        const int ht = 2 * wt + (F.lane >> 5), cgb = ht % 11, seg = ht / 11, c0 = (cgb * 32 + (F.lane & 31)) * 8, m0 = seg * 16;
        f32x4 wg[3][2], wv[3][2], bg[2], bv[2];
#pragma unroll
        for (int h = 0; h < 2; ++h) {
#pragma unroll
            for (int j = 0; j < 3; ++j) { wg[j][h] = *(const f32x4*)(cw + j * FF2 + c0 + 4 * h); wv[j][h] = *(const f32x4*)(cw + j * FF2 + FF + c0 + 4 * h); }
            bg[h] = *(const f32x4*)(cb + c0 + 4 * h); bv[h] = *(const f32x4*)(cb + FF + c0 + 4 * h);
        }
        v4u g1, g2, v1, v2;
        if ((m0 & (SEQ - 1)) == 0) { g1 = g2 = v1 = v2 = (v4u){0u, 0u, 0u, 0u}; }
        else { g1 = *(const v4u*)(U + (size_t)(m0 - 1) * FF2 + c0); v1 = *(const v4u*)(U + (size_t)(m0 - 1) * FF2 + FF + c0); g2 = *(const v4u*)(U + (size_t)(m0 - 2) * FF2 + c0); v2 = *(const v4u*)(U + (size_t)(m0 - 2) * FF2 + FF + c0); }
#pragma unroll 4
        for (int r = 0; r < 16; ++r) {
            const int m = m0 + r;
            const v4u g0 = *(const v4u*)(U + (size_t)m * FF2 + c0), v0 = *(const v4u*)(U + (size_t)m * FF2 + FF + c0);
            v4u o;
#pragma unroll
            for (int e = 0; e < 4; ++e) {
                const int h = e >> 1, q = (e & 1) * 2;
                const float ga = bg[h][q] + wg[0][h][q] * __uint_as_float(g2[e] << 16) + wg[1][h][q] * __uint_as_float(g1[e] << 16) + wg[2][h][q] * __uint_as_float(g0[e] << 16);
                const float gb = bg[h][q + 1] + wg[0][h][q + 1] * __uint_as_float(g2[e] & 0xffff0000u) + wg[1][h][q + 1] * __uint_as_float(g1[e] & 0xffff0000u) + wg[2][h][q + 1] * __uint_as_float(g0[e] & 0xffff0000u);
                const float va = bv[h][q] + wv[0][h][q] * __uint_as_float(v2[e] << 16) + wv[1][h][q] * __uint_as_float(v1[e] << 16) + wv[2][h][q] * __uint_as_float(v0[e] << 16);
                const float vb = bv[h][q + 1] + wv[0][h][q + 1] * __uint_as_float(v2[e] & 0xffff0000u) + wv[1][h][q + 1] * __uint_as_float(v1[e] & 0xffff0000u) + wv[2][h][q + 1] * __uint_as_float(v0[e] & 0xffff0000u);
                o[e] = pk2(silu(ga) * va, silu(gb) * vb);
            }
            *(v4u*)(A + (size_t)m * FF + c0) = o;
            g2 = g1; g1 = g0; v2 = v1; v1 = v0;
        }
    }
}

__device__ __forceinline__ void pass1_naive(Frame& F) {
    const bf16* KT = (const bf16*)(F.ws + WS_BIG + 32 * MiB); const bf16* VT = (const bf16*)(F.ws + WS_BIG + 64 * MiB); bf16* RS = (bf16*)(F.ws + WS_R);
    const float* scg = (const float*)(F.ws + WS_SCG);
    for (int vt = F.vcu * 512 + F.tid; vt < 8 * 256 * 64; vt += F.G * 512) {
        const int bh = vt >> 14, rem = vt & 16383, dk = rem & 255, dv0 = (rem >> 8) * 8, b = bh >> 2, h = bh & 3;
        const float gch = scg[h];
        float R[8];
#pragma unroll
        for (int e = 0; e < 8; ++e) R[e] = 0.f;
        const bf16* kp = KT + (size_t)(b * SEQ) * 1024 + h * 256 + dk;
        for (int n = 0; n < NCH; ++n) {
            bf16* rb = RS + (((size_t)bh * 64 + n) * 512 + dv0) * 256 + dk;
#pragma unroll
            for (int e = 0; e < 8; ++e) rb[e * 256] = (bf16)f2bf(R[e]);
            if (n == NCH - 1) break;
            const bf16* vp = VT + (((size_t)bh * 64 + n) * 512 + dv0) * 128;
            float u[8];
#pragma unroll
            for (int e = 0; e < 8; ++e) u[e] = 0.f;
            for (int j0 = 0; j0 < 128; j0 += 8) {
                float kv[8];
#pragma unroll
                for (int jj = 0; jj < 8; ++jj) kv[jj] = bf2f(kp[(size_t)(n * 128 + j0 + jj) * 1024]);
#pragma unroll
                for (int e = 0; e < 8; ++e) { const v4u w = *(const v4u*)(vp + e * 128 + j0);
#pragma unroll
                    for (int q = 0; q < 4; ++q) { u[e] += kv[2 * q] * __uint_as_float(w[q] << 16); u[e] += kv[2 * q + 1] * __uint_as_float(w[q] & 0xffff0000u); } }
            }
#pragma unroll
            for (int e = 0; e < 8; ++e) R[e] = gch * (R[e] + u[e]);
        }
    }
}
__device__ __forceinline__ void pass2_naive(Frame& F) {
    const bf16* QT = (const bf16*)(F.ws + WS_BIG); const bf16* KT = (const bf16*)(F.ws + WS_BIG + 32 * MiB); const bf16* VT = (const bf16*)(F.ws + WS_BIG + 64 * MiB);
    bf16* G = (bf16*)(F.ws + WS_BIG + 128 * MiB); const bf16* RS = (const bf16*)(F.ws + WS_R);
    LAS bf16* P = (LAS bf16*)F.lds;
    for (int it = F.vcu; it < 512; it += F.G) {
        const int bh = (it & 255) >> 5, n = (it & 31) + 32 * (it >> 8), b = bh >> 2, h = bh & 3;
        const bf16* q = QT + (size_t)(b * SEQ + n * 128) * 1024 + h * 256; const bf16* k = KT + (size_t)(b * SEQ + n * 128) * 1024 + h * 256;
        for (int e = F.tid; e < 128 * 128; e += 512) {
            const int i = e >> 7, j = e & 127; float s = 0.f;
            if (j <= i) { const v4u* qi = (const v4u*)(q + (size_t)i * 1024); const v4u* kj = (const v4u*)(k + (size_t)j * 1024);
                for (int c = 0; c < 32; ++c) s += dot8(qi[c], kj[c]); }
            P[e] = (bf16)f2bf(s);
        }
        __syncthreads();
        for (int rr = 0; rr < 16; ++rr) {
            const int i = F.wave + 8 * rr; float o[8]; float sum = 0.f;
            const v4u* qrow = (const v4u*)(q + (size_t)i * 1024); const LAS v4u* prow = (const LAS v4u*)(P + i * 128);
#pragma unroll
            for (int e = 0; e < 8; ++e) {
                const int dv = F.lane + 64 * e;
                const v4u* vrow = (const v4u*)(VT + (((size_t)bh * 64 + n) * 512 + dv) * 128); const v4u* rrow = (const v4u*)(RS + (((size_t)bh * 64 + n) * 512 + dv) * 256);
                float s = 0.f;
                for (int c = 0; c < 16; ++c) s += dot8(prow[c], vrow[c]);
                for (int c = 0; c < 32; ++c) s += dot8(qrow[c], rrow[c]);
                o[e] = s; sum += s;
            }
            const float mu = wave_sum(sum) * (1.0f / 512.0f); float sq = 0.f;
#pragma unroll
            for (int e = 0; e < 8; ++e) { o[e] -= mu; sq += o[e] * o[e]; }
            const float rstd = __builtin_amdgcn_rsqf(wave_sum(sq) * (1.0f / 512.0f) + NORM_EPS);
#pragma unroll
            for (int e = 0; e < 8; ++e) { bf16* gp = G + (size_t)(b * SEQ + n * 128 + i) * 2048 + h * 512 + F.lane + 64 * e; *gp = (bf16)f2bf(bf2f(*gp) * o[e] * rstd); }
        }
        __syncthreads();
    }
}
__device__ __forceinline__ void attn_naive(Frame& F, int li) {
    bf16* Q = (bf16*)(F.ws + WS_BIG); const bf16* KS = (const bf16*)(F.ws + WS_KSH); const bf16* VS = (const bf16*)(F.ws + WS_VSH);
    const float* biasT = (const float*)(F.ws + WS_BIAS); const float* sinks = F.in[I_SINKS] + li * 16;
    LAS float* qs = (LAS float*)(F.lds) + F.wave * 256;
    const int gw = F.vcu * NWAVES + F.wave, NGW = F.G * NWAVES;
    for (int item = gw; item < M * SHEADS; item += NGW) {
        const int m = item >> 4, head = item & 15, hk = head >> 2, b = m >> 13, s = m & (SEQ - 1);
        bf16* qp = Q + (size_t)m * 1024 + head * 64 + F.lane;
        qs[F.lane] = bf2f(*qp);
        const float sink = sinks[head];
        float sc[2]; bool valid[2];
#pragma unroll
        for (int t = 0; t < 2; ++t) {
            const int kk = F.lane + 64 * t, kpos = s - 127 + kk, dist = 127 - kk; valid[t] = kpos >= 0; float d = 0.f;
            if (valid[t]) { const v4u* kr = (const v4u*)(KS + (size_t)(b * SEQ + kpos) * 256 + hk * 64);
#pragma unroll
                for (int c = 0; c < 8; ++c) { const v4u w = kr[c];
#pragma unroll
                    for (int e = 0; e < 4; ++e) { d += qs[c * 8 + 2 * e] * __uint_as_float(w[e] << 16); d += qs[c * 8 + 2 * e + 1] * __uint_as_float(w[e] & 0xffff0000u); } } }
            sc[t] = valid[t] ? d * 0.125f + biasT[head * 128 + dist] : -INFINITY;
        }
        const float mx = fmaxf(wave_max(fmaxf(sc[0], sc[1])), sink);
        const float e0 = valid[0] ? __expf(sc[0] - mx) : 0.f, e1 = valid[1] ? __expf(sc[1] - mx) : 0.f;
        const float den = wave_sum(e0 + e1) + __expf(sink - mx), rden = 1.0f / den;
        qs[64 + F.lane] = e0 * rden; qs[128 + F.lane] = e1 * rden;
        float o = 0.f; const int kk0 = (127 - s) > 0 ? (127 - s) : 0;
        const bf16* vp = VS + (size_t)(b * 256 + hk * 64 + F.lane) * SEQ + (s - 127);
        for (int kk = kk0; kk < 128; ++kk) o += qs[64 + kk] * bf2f(vp[kk]);
        *qp = (bf16)f2bf(o);
    }
}


typedef short v4i16_t __attribute__((ext_vector_type(4)));
typedef unsigned v2u __attribute__((ext_vector_type(2)));
#define MFMA16(a, b, c) __builtin_amdgcn_mfma_f32_16x16x32_bf16((a), (b), (c), 0, 0, 0)
__device__ __forceinline__ unsigned pk2h(float lo, float hi) { unsigned r; asm volatile("v_cvt_pk_bf16_f32 %0, %1, %2" : "=v"(r) : "v"(lo), "v"(hi)); return r; }

__device__ __forceinline__ void pass1_fast(Frame& F) {
    const bf16* KT = (const bf16*)(F.ws + WS_BIG + 32 * MiB); const bf16* VT = (const bf16*)(F.ws + WS_BIG + 64 * MiB); bf16* RS = (bf16*)(F.ws + WS_R);
    const int bh = F.vcu >> 5, blk = F.vcu & 31, dkb = blk & 3, dvb = blk >> 2, b = bh >> 2, h = bh & 3;
    const float gch = ((const float*)(F.ws + WS_SCG))[h];
    constexpr int KTILE = 16384, VSTRIDE = 272, BUF = KTILE + 64 * VSTRIDE;
    const int tid = F.tid, lane = F.lane, c = lane & 15, g = lane >> 4, pair = F.wave & 1, nt = F.wave >> 1;
    const bf16* kg[2]; int kl[2]; bool ksw[2]; const bf16* vg[2]; int vl[2];
#pragma unroll
    for (int i = 0; i < 2; ++i) {
        const int ch = tid + 512 * i, row = ch >> 3, cc = ch & 7;
        kg[i] = KT + (size_t)(b * SEQ + row) * 1024 + h * 256 + dkb * 64 + cc * 8;
        kl[i] = row * 128 + ((cc ^ (((row >> 3) & 1) << 2)) << 4); ksw[i] = (row >> 1) & 1;
        const int vr = ch >> 4, vc = ch & 15;
        vg[i] = VT + (((size_t)bh * 64) * 512 + dvb * 64 + vr) * 128 + vc * 8;
        vl[i] = KTILE + vr * VSTRIDE + vc * 16;
    }
    const int q4 = (lane >> 2) & 3, p4 = lane & 3;
    int aoff[2][2];
#pragma unroll
    for (int s = 0; s < 2; ++s)
#pragma unroll
        for (int t = 0; t < 2; ++t) { const int row = 8 * g + 4 * s + q4; const int unit = (pair * 8 + 2 * p4 + t) ^ ((row >> 1) & 1) ^ (((row >> 3) & 1) << 3); aoff[s][t] = row * 128 + unit * 8; }
    const int boff = KTILE + (16 * nt + c) * VSTRIDE + 16 * g;
    bf16* rdst = RS + (((size_t)bh * 64) * 512 + dvb * 64 + 16 * nt + c) * 256 + dkb * 64 + 32 * pair + 8 * g;
    f32x4 acc0 = {0.f, 0.f, 0.f, 0.f}, acc1 = {0.f, 0.f, 0.f, 0.f};
    v4u ra[4], rb[4];
#define P1_LOAD(n, r) do { _Pragma("unroll") for (int i_ = 0; i_ < 2; ++i_) { r[i_] = *(const v4u*)(kg[i_] + (size_t)(n) * 128 * 1024); r[2 + i_] = *(const v4u*)(vg[i_] + (size_t)(n) * 512 * 128); } } while (0)
#define P1_WRITE(r, bufo) do { _Pragma("unroll") for (int i_ = 0; i_ < 2; ++i_) { v4u w_ = r[i_]; if (ksw[i_]) w_ = (v4u){w_.z, w_.w, w_.x, w_.y}; \
        *(LAS v4u*)(F.lds + (bufo) + kl[i_]) = w_; *(LAS v4u*)(F.lds + (bufo) + vl[i_]) = r[2 + i_]; } } while (0)
#define P1_STEP(n, bufo, rnext, rload) do { \
        if ((n) + 2 <= NCH - 2) P1_LOAD((n) + 2, rload); \
        { v4u w_; w_.x = pk2h(acc0[0], acc0[1]); w_.y = pk2h(acc0[2], acc0[3]); w_.z = pk2h(acc1[0], acc1[1]); w_.w = pk2h(acc1[2], acc1[3]); *(v4u*)(rdst + (size_t)(n) * 512 * 256) = w_; } \
        if ((n) <= NCH - 2) { \
            _Pragma("unroll") for (int ks_ = 0; ks_ < 4; ++ks_) { \
                const LAS unsigned char* kb_ = F.lds + (bufo) + ks_ * 4096; \
                const v4i16_t x00 = __builtin_amdgcn_ds_read_tr16_b64_v4i16((LAS v4i16_t*)(kb_ + aoff[0][0])), x10 = __builtin_amdgcn_ds_read_tr16_b64_v4i16((LAS v4i16_t*)(kb_ + aoff[1][0])); \
                const v4i16_t x01 = __builtin_amdgcn_ds_read_tr16_b64_v4i16((LAS v4i16_t*)(kb_ + aoff[0][1])), x11 = __builtin_amdgcn_ds_read_tr16_b64_v4i16((LAS v4i16_t*)(kb_ + aoff[1][1])); \
                const bf16x8 bv_ = *(const LAS bf16x8*)(F.lds + (bufo) + boff + ks_ * 64); \
                const bf16x8 a0_ = {x00[0], x00[1], x00[2], x00[3], x10[0], x10[1], x10[2], x10[3]}, a1_ = {x01[0], x01[1], x01[2], x01[3], x11[0], x11[1], x11[2], x11[3]}; \
                acc0 = MFMA16(a0_, bv_, acc0); acc1 = MFMA16(a1_, bv_, acc1); } \
            acc0 = acc0 * gch; acc1 = acc1 * gch; } \
        if ((n) + 1 <= NCH - 2) P1_WRITE(rnext, ((bufo) == 0 ? BUF : 0)); \
        __syncthreads(); } while (0)
    P1_LOAD(0, ra); P1_LOAD(1, rb);
    P1_WRITE(ra, 0);
    __syncthreads();
    for (int n = 0; n < NCH; n += 2) { P1_STEP(n, 0, rb, ra); P1_STEP(n + 1, BUF, ra, rb); }
#undef P1_LOAD
#undef P1_WRITE
#undef P1_STEP
}

__device__ __forceinline__ void pass2_fast(Frame& F) {
    const bf16* QT = (const bf16*)(F.ws + WS_BIG); const bf16* KT = (const bf16*)(F.ws + WS_BIG + 32 * MiB); const bf16* VT = (const bf16*)(F.ws + WS_BIG + 64 * MiB);
    bf16* G = (bf16*)(F.ws + WS_BIG + 128 * MiB); const bf16* RS = (const bf16*)(F.ws + WS_R);
    constexpr int PSTR = 272;
    LAS unsigned char* Pl = F.lds; LAS float* st = (LAS float*)(F.lds + 36864);
    const int lane = F.lane, c = lane & 15, g = lane >> 4, wr = F.wave >> 2, wc = F.wave & 3;
    for (int it = F.vcu; it < 512; it += F.G) {
        const int bh = (it & 255) >> 5, n = (it & 31) + 32 * (it >> 8), b = bh >> 2, h = bh & 3;
        const bf16* q = QT + (size_t)(b * SEQ + n * 128) * 1024 + h * 256; const bf16* k = KT + (size_t)(b * SEQ + n * 128) * 1024 + h * 256;
        const bf16* vt = VT + ((size_t)bh * 64 + n) * 512 * 128; const bf16* rt = RS + ((size_t)bh * 64 + n) * 512 * 256;
        {
            f32x4 s[2][4];
#pragma unroll
            for (int t = 0; t < 2; ++t)
#pragma unroll
                for (int mi = 0; mi < 4; ++mi) s[t][mi] = (f32x4){0.f, 0.f, 0.f, 0.f};
            const bf16* ka = k + (size_t)(32 * wc + c) * 1024 + 8 * g; const bf16* qb = q + (size_t)(64 * wr + c) * 1024 + 8 * g;
#pragma unroll 2
            for (int ks = 0; ks < 8; ++ks) {
                bf16x8 a[2], bq[4];
#pragma unroll
                for (int t = 0; t < 2; ++t) a[t] = *(const bf16x8*)(ka + (size_t)(16 * t) * 1024 + 32 * ks);
#pragma unroll
                for (int mi = 0; mi < 4; ++mi) bq[mi] = *(const bf16x8*)(qb + (size_t)(16 * mi) * 1024 + 32 * ks);
#pragma unroll
                for (int t = 0; t < 2; ++t)
#pragma unroll
                    for (int mi = 0; mi < 4; ++mi) s[t][mi] = MFMA16(a[t], bq[mi], s[t][mi]);
            }
#pragma unroll
            for (int t = 0; t < 2; ++t)
#pragma unroll
                for (int mi = 0; mi < 4; ++mi) {
                    const int i = 64 * wr + 16 * mi + c, j0 = 32 * wc + 16 * t + 4 * g;
                    const float v0 = (j0 + 0 <= i) ? s[t][mi][0] : 0.f, v1 = (j0 + 1 <= i) ? s[t][mi][1] : 0.f, v2 = (j0 + 2 <= i) ? s[t][mi][2] : 0.f, v3 = (j0 + 3 <= i) ? s[t][mi][3] : 0.f;
                    v2u w; w.x = pk2h(v0, v1); w.y = pk2h(v2, v3);
                    *(LAS v2u*)(Pl + i * PSTR + j0 * 2) = w;
                }
        }
        __syncthreads();
        f32x4 acc[4][8];
#pragma unroll
        for (int mi = 0; mi < 4; ++mi)
#pragma unroll
            for (int ni = 0; ni < 8; ++ni) acc[mi][ni] = (f32x4){0.f, 0.f, 0.f, 0.f};
        {
            const bf16* va = vt + (size_t)(128 * wc + c) * 128 + 8 * g; const LAS unsigned char* pb = Pl + (64 * wr + c) * PSTR + 16 * g;
            const int nks = wr == 0 ? 2 : 4;
            for (int ks = 0; ks < nks; ++ks) {
                bf16x8 a[8], bp[4];
#pragma unroll
                for (int ni = 0; ni < 8; ++ni) a[ni] = *(const bf16x8*)(va + (size_t)(16 * ni) * 128 + 32 * ks);
#pragma unroll
                for (int mi = 0; mi < 4; ++mi) bp[mi] = *(const LAS bf16x8*)(pb + (16 * mi) * PSTR + 64 * ks);
#pragma unroll
                for (int mi = 0; mi < 4; ++mi)
#pragma unroll
                    for (int ni = 0; ni < 8; ++ni) acc[mi][ni] = MFMA16(a[ni], bp[mi], acc[mi][ni]);
            }
        }
        {
            const bf16* ra = rt + (size_t)(128 * wc + c) * 256 + 8 * g; const bf16* qb = q + (size_t)(64 * wr + c) * 1024 + 8 * g;
#pragma unroll 2
            for (int ks = 0; ks < 8; ++ks) {
                bf16x8 a[8], bq[4];
#pragma unroll
                for (int ni = 0; ni < 8; ++ni) a[ni] = *(const bf16x8*)(ra + (size_t)(16 * ni) * 256 + 32 * ks);
#pragma unroll
                for (int mi = 0; mi < 4; ++mi) bq[mi] = *(const bf16x8*)(qb + (size_t)(16 * mi) * 1024 + 32 * ks);
#pragma unroll
                for (int mi = 0; mi < 4; ++mi)
#pragma unroll
                    for (int ni = 0; ni < 8; ++ni) acc[mi][ni] = MFMA16(a[ni], bq[mi], acc[mi][ni]);
            }
        }
#pragma unroll
        for (int mi = 0; mi < 4; ++mi) {
            float s = 0.f;
#pragma unroll
            for (int ni = 0; ni < 8; ++ni) s += (acc[mi][ni][0] + acc[mi][ni][1]) + (acc[mi][ni][2] + acc[mi][ni][3]);
            s += __shfl_xor(s, 16); s += __shfl_xor(s, 32);
            const float mw = s * (1.0f / 128.0f); float qq = 0.f;
#pragma unroll
            for (int ni = 0; ni < 8; ++ni) { const f32x4 d = acc[mi][ni] - mw; qq += (d[0] * d[0] + d[1] * d[1]) + (d[2] * d[2] + d[3] * d[3]); }
            qq += __shfl_xor(qq, 16); qq += __shfl_xor(qq, 32);
            if (g == 0) { const int i = 64 * wr + 16 * mi + c; st[(i * 4 + wc) * 2 + 0] = mw; st[(i * 4 + wc) * 2 + 1] = qq; }
        }
        __syncthreads();
#pragma unroll
        for (int mi = 0; mi < 4; ++mi) {
            const int i = 64 * wr + 16 * mi + c;
            const f32x4 s01 = *(const LAS f32x4*)(st + i * 8), s23 = *(const LAS f32x4*)(st + i * 8 + 4);
            const float mean = ((s01[0] + s01[2]) + (s23[0] + s23[2])) * 0.25f;
            const float d0 = s01[0] - mean, d1 = s01[2] - mean, d2 = s23[0] - mean, d3 = s23[2] - mean;
            const float m2 = (s01[1] + s01[3]) + (s23[1] + s23[3]) + 128.0f * ((d0 * d0 + d1 * d1) + (d2 * d2 + d3 * d3));
            const float rstd = __builtin_amdgcn_rsqf(m2 * (1.0f / 512.0f) + NORM_EPS);
            bf16* gp = G + (size_t)(b * SEQ + n * 128 + i) * 2048 + h * 512 + 128 * wc + 4 * g;
#pragma unroll
            for (int ni = 0; ni < 8; ++ni) {
                const v2u gv = *(const v2u*)(gp + 16 * ni);
                const f32x4 o = (acc[mi][ni] - mean) * rstd;
                v2u w; w.x = pk2h(__uint_as_float(gv.x << 16) * o[0], __uint_as_float(gv.x & 0xffff0000u) * o[1]); w.y = pk2h(__uint_as_float(gv.y << 16) * o[2], __uint_as_float(gv.y & 0xffff0000u) * o[3]);
                *(v2u*)(gp + 16 * ni) = w;
            }
        }
    }
}

__device__ __forceinline__ void attn_fast(Frame& F, int li) {
    bf16* Q = (bf16*)(F.ws + WS_BIG); const bf16* KS = (const bf16*)(F.ws + WS_KSH); const bf16* VTS = (const bf16*)(F.ws + WS_VSH);
    const float* sinks = F.in[I_SINKS] + li * 16;
    LAS float* bl = (LAS float*)(F.lds);
    for (int i = F.tid; i < 16 * 128; i += 512) bl[i] = ((const float*)(F.ws + WS_BIAS))[i];
    __syncthreads();
    const int lane = F.lane, c = lane & 15, g4 = lane >> 4, hg = F.wave >> 1, qh = F.wave & 1;
    for (int it = F.vcu; it < 512; it += F.G) {
        const int b = it >> 8, n = (it >> 2) & 63, hk = it & 3, head = hk * 4 + hg;
        const float sink = sinks[head];
        const LAS float* bh_ = bl + head * 128;
        for (int mt = 0; mt < 4; ++mt) {
            const int i0 = 64 * qh + 16 * mt;
            const int kp0 = n * 128 - 128 + i0;
            bf16* qrow = Q + (size_t)(b * SEQ + n * 128 + i0 + c) * 1024 + head * 64;
            const bf16x8 q0 = *(const bf16x8*)(qrow + 8 * g4), q1 = *(const bf16x8*)(qrow + 32 + 8 * g4);
            f32x4 s[10];
#pragma unroll
            for (int kt = 0; kt < 9; ++kt) {
                int kp = kp0 + 16 * kt + c; kp = kp < 0 ? 0 : (kp > SEQ - 1 ? SEQ - 1 : kp);
                const bf16* kr = KS + (size_t)(b * SEQ + kp) * 256 + hk * 64 + 8 * g4;
                const bf16x8 k0 = *(const bf16x8*)(kr), k1 = *(const bf16x8*)(kr + 32);
                f32x4 z = {0.f, 0.f, 0.f, 0.f};
                z = MFMA16(k0, q0, z); s[kt] = MFMA16(k1, q1, z);
            }
            float mx = sink;
#pragma unroll
            for (int kt = 0; kt < 9; ++kt)
#pragma unroll
                for (int e = 0; e < 4; ++e) {
                    const int jr = 16 * kt + 4 * g4 + e, dist = 128 + c - jr;
                    const bool ok = (dist >= 0) && (dist < 128) && (kp0 + jr >= 0);
                    const float v = ok ? s[kt][e] * 0.125f + bh_[dist & 127] : -INFINITY;
                    s[kt][e] = v; mx = fmaxf(mx, v);
                }
            mx = fmaxf(mx, __shfl_xor(mx, 16)); mx = fmaxf(mx, __shfl_xor(mx, 32));
            float sum = 0.f;
#pragma unroll
            for (int kt = 0; kt < 9; ++kt)
#pragma unroll
                for (int e = 0; e < 4; ++e) { const float p = __expf(s[kt][e] - mx); s[kt][e] = p; sum += p; }
            sum += __shfl_xor(sum, 16); sum += __shfl_xor(sum, 32);
            const float rden = 1.0f / (sum + __expf(sink - mx));
            s[9] = (f32x4){0.f, 0.f, 0.f, 0.f};
            f32x4 o[4];
#pragma unroll
            for (int dt = 0; dt < 4; ++dt) o[dt] = (f32x4){0.f, 0.f, 0.f, 0.f};
            const bf16* vrow = VTS + (size_t)(b * 256 + hk * 64 + c) * SEQ;
#pragma unroll
            for (int kk = 0; kk < 5; ++kk) {
                v4u pw; pw.x = pk2h(s[2 * kk][0] * rden, s[2 * kk][1] * rden); pw.y = pk2h(s[2 * kk][2] * rden, s[2 * kk][3] * rden);
                pw.z = pk2h(s[2 * kk + 1][0] * rden, s[2 * kk + 1][1] * rden); pw.w = pk2h(s[2 * kk + 1][2] * rden, s[2 * kk + 1][3] * rden);
                const bf16x8 pb = __builtin_bit_cast(bf16x8, pw);
                int ka = kp0 + 32 * kk + 4 * g4, kb = ka + 16;
                ka = ka < 0 ? 0 : (ka > SEQ - 4 ? SEQ - 4 : ka); kb = kb < 0 ? 0 : (kb > SEQ - 4 ? SEQ - 4 : kb);
#pragma unroll
                for (int dt = 0; dt < 4; ++dt) {
                    const v2u va = *(const v2u*)(vrow + (size_t)(16 * dt) * SEQ + ka), vb = *(const v2u*)(vrow + (size_t)(16 * dt) * SEQ + kb);
                    const v4u vw = {va.x, va.y, vb.x, vb.y};
                    o[dt] = MFMA16(__builtin_bit_cast(bf16x8, vw), pb, o[dt]);
                }
            }
#pragma unroll
            for (int dt = 0; dt < 4; ++dt) { v2u w; w.x = pk2h(o[dt][0], o[dt][1]); w.y = pk2h(o[dt][2], o[dt][3]); *(v2u*)(qrow + 16 * dt + 4 * g4) = w; }
        }
    }
    __syncthreads();
}

constexpr int N_PHASES = 2 + 2 * 9 + 2 * 8;
struct Args { const float* in[19]; float* out; unsigned char* ws; int ph_lo, ph_hi; };
static_assert(sizeof(Args) == 19 * 8 + 8 + 8 + 8, "Args has no padding");

__global__ void __launch_bounds__(NWAVES * 64, 2) yoco_fwd(Args args) {
    extern __shared__ __attribute__((aligned(16))) unsigned char lds[];
    Frame F;
    F.lds = (LAS unsigned char*)lds;
    F.MISC = (volatile LAS unsigned*)(F.lds + MISC_OFF);
    F.G = gridDim.x; { const int bx = blockIdx.x; F.vcu = (F.G % 8 == 0) ? (bx % 8) * (F.G / 8) + bx / 8 : bx; }
    for (int u = threadIdx.x; u < (LDS_BYTES - LDSCTL_OFF) / 4; u += NWAVES * 64) ((LAS unsigned*)(F.lds + LDSCTL_OFF))[u] = 0u;
    __syncthreads();
    XcdBarrier bar; bar.bar = (unsigned*)(args.ws + WS_CTL) + CW_BAR; bar.x = 0; bar.st = nullptr;
    if (MK_N_LAUNCHES == 1) bar = xcd_barrier_post((unsigned*)(args.ws + WS_CTL) + CW_BAR, F.MISC + 8);

    int ph_first = args.ph_lo;
    if (ph_first == 0) {
        { int tid = threadIdx.x; asm volatile("" : "+v"(tid)); F.tid = tid; F.lane = tid & 63; F.wave = __builtin_amdgcn_readfirstlane(tid >> 6); }
        const Args __attribute__((address_space(4)))* ap = (const Args __attribute__((address_space(4)))*)__builtin_amdgcn_kernarg_segment_ptr();
        asm volatile("" : "+s"(ap));
        F.in = (const float* __attribute__((address_space(4)))*)&ap->in[0]; F.out = ap->out; F.ws = ap->ws; F.ctl = (gu32*)(F.ws + WS_CTL);
        phase_mods(F); phase_tables(F); phase_weights(F, 0);
        if (args.ph_hi > 1) { if (MK_N_LAUNCHES == 1) xcd_barrier(bar); }
        ph_first = 1;
    }
    for (int ph = ph_first; ph < args.ph_hi; ++ph) {
        { int tid = threadIdx.x; asm volatile("" : "+v"(tid)); F.tid = tid; F.lane = tid & 63; F.wave = __builtin_amdgcn_readfirstlane(tid >> 6); }
        const Args __attribute__((address_space(4)))* ap = (const Args __attribute__((address_space(4)))*)__builtin_amdgcn_kernarg_segment_ptr();
        asm volatile("" : "+s"(ap));
        F.in = (const float* __attribute__((address_space(4)))*)&ap->in[0]; F.out = ap->out; F.ws = ap->ws; F.ctl = (gu32*)(F.ws + WS_CTL);
        unsigned char* ws = F.ws;
        bf16* const H = (bf16*)(ws + WS_R); bf16* const HKV = (bf16*)(ws + WS_R + 32 * MiB); bf16* const ACT = (bf16*)(ws + WS_R);
        bf16* const BIG = (bf16*)(ws + WS_BIG);
        const float* const MODS = (const float*)(ws + WS_MODS); const float* const KVMOD = (const float*)(ws + WS_KVMOD);
        int layer = -1, sub = -1;
        if (ph >= 2) { int p = ph - 2; if (p < 18) { layer = p / 9; sub = p % 9; } else { p -= 18; layer = 2 + p / 8; sub = 10 + p % 8; } }
        const bool ret = layer >= 0 && layer < 2;
        const bool is_rp_start = (ph == 1);
        const bool is_rp_mid = (sub == 4) || (sub == 13);
        const bool is_rp_end = (sub == 8) || (sub == 17);
        const bool is_conv = (sub == 6) || (sub == 15);
        const bool is_gemm_out = (sub == 3) || (sub == 12);
        const bool is_gemm_up = (sub == 5) || (sub == 14);
        const bool is_gemm_down = (sub == 7) || (sub == 16);
        const bool is_gemm_q = (sub == 10);

        if (is_rp_start || is_rp_mid || is_rp_end) {
            RowPass P{};
            if (is_rp_start) {
                P.xsrc = F.in[I_X]; P.xdst = nullptr; P.y = nullptr;
                P.h1 = H; P.g1 = F.in[I_NORMG] + (0 * 4 + 0) * D; P.sc1 = MODS + 1 * D; P.sh1 = MODS + 0 * D; P.st1 = 6144;
            } else if (is_rp_mid) {
                P.xsrc = (layer == 0) ? F.in[I_X] : F.out; P.xdst = F.out;
                P.y = ret ? BIG : BIG + (size_t)16 * MiB;
                P.gpost = F.in[I_NORMG] + (layer * 4 + 1) * D; P.gate = MODS + (size_t)layer * 2 * 6144 + 2 * D; P.gstride = 6144;
                P.h1 = H; P.g1 = F.in[I_NORMG] + (layer * 4 + 2) * D; P.sc1 = MODS + (size_t)layer * 2 * 6144 + 4 * D; P.sh1 = MODS + (size_t)layer * 2 * 6144 + 3 * D; P.st1 = 6144;
            } else {
                P.xsrc = F.out; P.xdst = F.out; P.y = BIG;
                P.gpost = F.in[I_NORMG] + (layer * 4 + 3) * D; P.gate = MODS + (size_t)layer * 2 * 6144 + 5 * D; P.gstride = 6144;
                if (layer < 3) { P.h1 = H; P.g1 = F.in[I_NORMG] + ((layer + 1) * 4 + 0) * D; P.sc1 = MODS + (size_t)(layer + 1) * 2 * 6144 + 1 * D; P.sh1 = MODS + (size_t)(layer + 1) * 2 * 6144; P.st1 = 6144; }
                if (layer == 1) { P.h2 = HKV; P.g2 = F.in[I_KVNG]; P.sc2 = KVMOD + D; P.sh2 = KVMOD; P.st2 = 2048; }
            }
            phase_rowpass(F, P);
            if (is_rp_end && layer < 3) phase_weights(F, layer + 1);
        }

        if (sub == 0) {
            pg8::Gemm g{H, (const bf16*)(ws + WS_WT_IN), M, 4096, D}; pg8::StaticOrder S; S.init(M, 4096, F.G, (int)blockIdx.x);
            pg8::EpiRetQKG E{BIG, BIG + (size_t)16 * MiB, BIG + (size_t)64 * MiB, (const float*)(ws + WS_COS), (const float*)(ws + WS_SIN), (const float*)(ws + WS_SCQ), (const float*)(ws + WS_SCK)};
            pg8::gemm_phase<pg8::EpiRetQKG, pg8::StaticOrder, true, true>(F.lds + RING_OFF, g, S, E);
        }
        if (sub == 0 || (sub == 10 && layer == 2)) {
            pg8::Gemm g{}; pg8::EpiVT E{}; int cid = (int)blockIdx.x;
            if (sub == 0) { g = pg8::Gemm{(const bf16*)(ws + WS_WT_IN) + (size_t)4096 * D, H, 2048, M, D}; E.VT = BIG + (size_t)32 * MiB; E.mode = 0; }
            else { g = pg8::Gemm{(const bf16*)(ws + WS_WT_KV) + (size_t)256 * D, HKV, 256, M, D}; E.VT = (bf16*)(ws + WS_VSH); E.mode = 1; cid = (cid + F.G / 2) % F.G; }
            pg8::StaticOrder S; S.init(g.M, g.N, F.G, cid);
            pg8::gemm_phase<pg8::EpiVT, pg8::StaticOrder, true, true>(F.lds + RING_OFF, g, S, E);
        }
#if NAIVE_P1
        if (sub == 1) { pass1_naive(F); }
#else
        if (sub == 1) { if (F.G == 256) pass1_fast(F); else pass1_naive(F); }
#endif
#if NAIVE_P2
        if (sub == 2) { pass2_naive(F); }
#else
        if (sub == 2) { pass2_fast(F); }
#endif
#if NAIVE_ATT
        if (sub == 11) { attn_naive(F, layer - 2); }
#else
        if (sub == 11) { attn_fast(F, layer - 2); }
#endif
        if (is_conv) { phase_conv(F, layer); }

        if (is_gemm_out || is_gemm_up || is_gemm_down || is_gemm_q) {
            const int ng = (is_gemm_q && layer == 2) ? 2 : 1;
            for (int gi = 0; gi < ng; ++gi) {
                pg8::Gemm g{}; pg8::EpiBf16S E{};
                E.scale = 1.0f; E.split_cols = 0; E.split_stride = 0;
                if (is_gemm_q) {
                    if (gi == 0) { g = pg8::Gemm{H, (const bf16*)(ws + WS_WT_IN), M, D, D}; E.O = BIG; E.ldc = D; }
                    else { g = pg8::Gemm{HKV, (const bf16*)(ws + WS_WT_KV), M, 256, D}; E.O = (bf16*)(ws + WS_KSH); E.ldc = 256; }
                } else if (is_gemm_out) {
                    if (ret) { g = pg8::Gemm{BIG + (size_t)64 * MiB, (const bf16*)(ws + WS_WT_OUT), M, D, 2048}; E.O = BIG; E.ldc = D; }
                    else { g = pg8::Gemm{BIG, (const bf16*)(ws + WS_WT_OUT), M, D, D}; E.O = BIG + (size_t)16 * MiB; E.ldc = D; }
                } else if (is_gemm_up) {
                    g = pg8::Gemm{H, (const bf16*)(ws + WS_WT_UP), M, FF2, D}; E.O = BIG; E.ldc = FF2;
                } else {
                    g = pg8::Gemm{ACT, (const bf16*)(ws + WS_WT_DOWN), M, D, FF}; E.O = BIG; E.ldc = D;
                }
                pg8::StaticOrder S; S.init(g.M, g.N, F.G, (int)blockIdx.x);
                pg8::gemm_phase<pg8::EpiBf16S, pg8::StaticOrder, true, true>(F.lds + RING_OFF, g, S, E);
            }
        }

        if (ph + 1 < args.ph_hi) { if (MK_N_LAUNCHES == 1) xcd_barrier(bar); }
    }
}

extern "C" void kernel_launch(void* const* d_in, const int* in_sizes, int n_in, void* d_out, int out_size, void* d_ws, size_t ws_size, hipStream_t stream) {
    static int grid = 0;
    if (grid == 0) {
        if (n_in != 19 || in_sizes[0] != M * D || out_size != M * D || ws_size < WS_END) { fprintf(stderr, "kernel_launch: unexpected problem (n_in %d, in0 %d, out %d, ws %zu); nothing launched\n", n_in, n_in > 0 ? in_sizes[0] : -1, out_size, ws_size); grid = -1; return; }
        int dev = 0, cus = 0;
        if (hipGetDevice(&dev) != hipSuccess || hipDeviceGetAttribute(&cus, hipDeviceAttributeMultiprocessorCount, dev) != hipSuccess) { grid = -1; return; }
        if (hipFuncSetAttribute((const void*)yoco_fwd, hipFuncAttributeMaxDynamicSharedMemorySize, LDS_BYTES) != hipSuccess) { fprintf(stderr, "kernel_launch: hipFuncSetAttribute failed\n"); grid = -1; return; }
        int per_cu = 0;
        if (hipOccupancyMaxActiveBlocksPerMultiprocessor(&per_cu, (const void*)yoco_fwd, NWAVES * 64, LDS_BYTES) != hipSuccess || per_cu < 1) fprintf(stderr, "kernel_launch: note: occupancy query reports %d workgroups per CU\n", per_cu);
        (void)hipGetLastError();
        grid = cus;
    }
    if (grid < 0) return;
    if (hipMemsetAsync((char*)d_ws + WS_CTL, 0, CTL_ZERO_BYTES, stream) != hipSuccess) return;
    Args a{};
    for (int i = 0; i < 19; ++i) a.in[i] = (const float*)d_in[i];
    a.out = (float*)d_out; a.ws = (unsigned char*)d_ws;
    if (MK_N_LAUNCHES == 1) {
        a.ph_lo = 0; a.ph_hi = N_PHASES;
        hipLaunchKernelGGL(yoco_fwd, dim3(grid), dim3(NWAVES * 64), LDS_BYTES, stream, a);
    } else {
        for (int ph = 0; ph < N_PHASES; ++ph) { a.ph_lo = ph; a.ph_hi = ph + 1; hipLaunchKernelGGL(yoco_fwd, dim3(grid), dim3(NWAVES * 64), LDS_BYTES, stream, a); }
    }
}
```

```cpp
#include <hip/hip_runtime.h>
#include <cstdio>
#include <cstdint>

#ifndef MK_N_LAUNCHES
#define MK_N_LAUNCHES 1
#endif
#ifndef PROBE_MASK
#define PROBE_MASK 0
#endif
#ifndef DRY_VARIANT
#define DRY_VARIANT 1
#endif
#ifndef NAIVE_P1
#define NAIVE_P1 0
#endif
#ifndef NAIVE_P2
#define NAIVE_P2 0
#endif
#ifndef NAIVE_ATT
#define NAIVE_ATT 0
#endif

constexpr int BATCH = 2, SEQ = 8192, D = 1024, M = BATCH * SEQ, DEPTH = 4;
constexpr int RH = 4, RDK = 256, RDV = 512, RC = 128, NCH = SEQ / RC;
constexpr int RETN = 6144, FF = 2816, FF2 = 5632;
constexpr int SHEADS = 16, SKVH = 4, SHD = 64, WIN = 128;
constexpr float NORM_EPS = 1e-6f;

namespace pg8 {
#define PG8_LAS __attribute__((address_space(3)))
typedef unsigned short bf16_t;
typedef short bf16x8 __attribute__((ext_vector_type(8)));
typedef float f32x4 __attribute__((ext_vector_type(4)));
typedef unsigned u32x4 __attribute__((ext_vector_type(4)));
constexpr int BM = 256, BK = 64, HALF = 128, HTB = HALF * BK * 2  , STAGE_BYTES = 8 * HTB, NXCD = 8, WGM = 8;

__host__ __device__ __forceinline__ int lds_byte(int r, int c) { const int st = (r >> 4) * 2 + (c >> 5), rr = r & 15, cc = c & 31, ob = rr * 64 + cc * 2; return st * 1024 + (ob ^ (((ob >> 9) & 1) << 5)); }
__host__ __device__ __forceinline__ void stage_rc(int b, int& R, int& C) { const int st = b / 1024, sb = b % 1024, swz = sb ^ (((sb >> 9) & 1) << 5); R = (st >> 1) * 16 + swz / 64; C = (st & 1) * 32 + (swz % 64) / 2; }
__host__ __device__ __forceinline__ int perm32(int rho) { const int n = rho >> 4, i = rho & 15; return 8 * (i >> 2) + 4 * n + (i & 3); }

struct Unit { int pm, pn; };
struct Gemm { const bf16_t* A; const bf16_t* Bt; int M, N, K; };

struct StaticOrder {
    int nM, nN, nwg, G, c;
    __host__ __device__ void init(int M, int N, int G_, int c_) { nM = M / BM; nN = N / BM; nwg = nM * nN; G = G_; c = c_; }
    __host__ __device__ bool next(int i, Unit& u) const {
        const long L = (long)i * G + c; if (L >= nwg) return false;
        int wgid = (int)L; { const int q = nwg / NXCD, r = nwg % NXCD, xcd = wgid % NXCD, off = wgid / NXCD; wgid = (xcd < r ? xcd * (q + 1) : r * (q + 1) + (xcd - r) * q) + off; }
        const int nig = WGM * nN, gid = wgid / nig, fm = gid * WGM, gsz = (nM - fm) < WGM ? (nM - fm) : WGM;
        u.pm = fm + ((wgid % nig) % gsz); u.pn = (wgid % nig) / gsz; return true;
    }
    __device__ __forceinline__ void a_ready(const Unit&) const {}
    __device__ __forceinline__ void done(const Unit&) const {}
};
__device__ __forceinline__ unsigned cvt_pk_bf16(float lo, float hi) { unsigned r; asm volatile("v_cvt_pk_bf16_f32 %0, %1, %2" : "=v"(r) : "v"(lo), "v"(hi)); return r; }
typedef float f32x2 __attribute__((ext_vector_type(2)));
__device__ __forceinline__ float silu_f(float x) { return x * __builtin_amdgcn_rcpf(1.0f + __expf(-x)); }
__device__ __forceinline__ u32x4 pack8(const f32x4 v0, const f32x4 v1) { u32x4 w; w.x = cvt_pk_bf16(v0[0], v0[1]); w.y = cvt_pk_bf16(v0[2], v0[3]); w.z = cvt_pk_bf16(v1[0], v1[1]); w.w = cvt_pk_bf16(v1[2], v1[3]); return w; }

struct EpiBf16S {
    static constexpr bool PERM = true, AFTER_DRAIN = false;
    bf16_t* O; int ldc; int split_cols; size_t split_stride; float scale;
    __device__ __forceinline__ void operator()(const f32x4 (&acc)[2][2][4][2], const Unit& u, int wr, int wc, int fr, int fq) const {
        const int row0 = u.pm * BM + wr * 64 + fr; int colt = u.pn * BM; bf16_t* base = O;
        if (split_cols) { const int t = colt / split_cols; base += (size_t)t * split_stride; colt -= t * split_cols; }
        const int col0 = colt + wc * 32 + 8 * fq;
#pragma unroll
        for (int ai = 0; ai < 2; ++ai)
#pragma unroll
            for (int m = 0; m < 4; ++m) { bf16_t* rowp = base + (size_t)(row0 + ai * HALF + m * 16) * ldc + col0;
#pragma unroll
                for (int bj = 0; bj < 2; ++bj) *(u32x4*)(rowp + bj * HALF) = pack8(acc[ai][bj][m][0] * scale, acc[ai][bj][m][1] * scale); }
    }
};

struct EpiRetQKG {
    static constexpr bool PERM = true, AFTER_DRAIN = false;
    bf16_t* QT; bf16_t* KT; bf16_t* G; const float* cosT; const float* sinT; const float* scq; const float* sck;
    __device__ __forceinline__ void operator()(const f32x4 (&acc)[2][2][4][2], const Unit& u, int wr, int wc, int fr, int fq) const {
        const int row0 = u.pm * BM + wr * 64 + fr;
        if (u.pn < 8) {
            const int head = u.pn & 3; const bool isk = u.pn >= 4;
            const float* sct = (isk ? sck : scq) + head * 128;
            const int ci = wc * 32 + 8 * fq;
#pragma unroll
            for (int ai = 0; ai < 2; ++ai)
#pragma unroll
                for (int m = 0; m < 4; ++m) {
                    const int row = row0 + ai * HALF + m * 16, pos = row & (SEQ - 1);
                    const float s = sct[pos & 127];
                    const f32x4 c0 = *(const f32x4*)(cosT + (size_t)pos * 128 + ci), c1 = *(const f32x4*)(cosT + (size_t)pos * 128 + ci + 4);
                    const f32x4 s0 = *(const f32x4*)(sinT + (size_t)pos * 128 + ci), s1 = *(const f32x4*)(sinT + (size_t)pos * 128 + ci + 4);
                    const f32x4 a0 = acc[ai][0][m][0], a1 = acc[ai][0][m][1], b0 = acc[ai][1][m][0], b1 = acc[ai][1][m][1];
                    const f32x4 o10 = (a0 * c0 - b0 * s0) * s, o11 = (a1 * c1 - b1 * s1) * s, o20 = (b0 * c0 + a0 * s0) * s, o21 = (b1 * c1 + a1 * s1) * s;
                    const int bb = row >> 13, nn = (row & (SEQ - 1)) >> 7, it = ((row & 127) >> 4);
                    bf16_t* tp = (isk ? KT : QT) + ((size_t)((bb * 64 + nn) * 4 + head) * 32768) + (size_t)((it * 8 + wc) * 512) + (fq * 16 + fr) * 8;
                    *(u32x4*)(tp) = pack8(o10, o11); *(u32x4*)(tp + 4 * 512) = pack8(o20, o21);
                }
        } else {
            const int gh = (u.pn - 8) >> 1, pb = ((u.pn - 8) & 1) * 8 + wc;
#pragma unroll
            for (int ai = 0; ai < 2; ++ai)
#pragma unroll
                for (int m = 0; m < 4; ++m) { const int row = row0 + ai * HALF + m * 16, bb = row >> 13, nn = (row & (SEQ - 1)) >> 7, it = ((row & 127) >> 4);
                    bf16_t* tp = G + (size_t)(bb * SEQ + nn * 128 + it * 16 + pb) * 2048 + gh * 512 + (fq * 16 + fr) * 8;
#pragma unroll
                    for (int bj = 0; bj < 2; ++bj) { f32x4 v0 = acc[ai][bj][m][0], v1 = acc[ai][bj][m][1];
#pragma unroll
                        for (int e = 0; e < 4; ++e) { v0[e] = silu_f(v0[e]); v1[e] = silu_f(v1[e]); }
                        *(u32x4*)(tp + (size_t)bj * 4 * 2048) = pack8(v0, v1); } }
        }
    }
};

struct EpiVT {
    static constexpr bool PERM = true, AFTER_DRAIN = false;
    bf16_t* VT; int mode;
    __device__ __forceinline__ void operator()(const f32x4 (&acc)[2][2][4][2], const Unit& u, int wr, int wc, int fr, int fq) const {
        const int ch0 = u.pm * BM + wr * 64 + fr, tok0 = u.pn * BM + wc * 32 + 8 * fq;
#pragma unroll
        for (int ai = 0; ai < 2; ++ai)
#pragma unroll
            for (int m = 0; m < 4; ++m) { const int ch = ch0 + ai * HALF + m * 16, h = ch >> 9, dv = ch & 511;
#pragma unroll
                for (int bj = 0; bj < 2; ++bj) { const int tok = tok0 + bj * HALF, b = tok >> 13, sp = tok & (SEQ - 1), chunk = sp >> 7, j = sp & 127;
                    bf16_t* p = mode == 0 ? VT + ((size_t)((b * 4 + h) * 64 + chunk) * 65536) + (size_t)(((dv >> 4) * 4 + wc) * 512) + (fq * 16 + fr) * 8 : VT + ((size_t)(b * 256 + ch) * SEQ + sp);
                    *(u32x4*)p = pack8(acc[ai][bj][m][0], acc[ai][bj][m][1]); } }
    }
};

template <class Epi, class Sched, bool ALIGN_EPI = false, bool SP2 = false>
__device__ __forceinline__ void gemm_phase(PG8_LAS unsigned char* lds, const Gemm g, const Sched& S, const Epi& E) {
    int tid_l = threadIdx.x; asm volatile("" : "+v"(tid_l));
    const int tid = tid_l, wid = __builtin_amdgcn_readfirstlane(tid >> 6), lane = tid & 63, wr = wid >> 2, wc = wid & 3, fr = lane & 15, fq = lane >> 4;
    const int K = g.K, nt = K / BK;
    unsigned voffA[2], voffB[2];
#pragma unroll
    for (int i = 0; i < 2; ++i) { int R, C; stage_rc(tid * 16 + i * 8192, R, C); const int Rb = Epi::PERM ? ((R & ~31) + perm32(R & 31)) : R;
        voffA[i] = (unsigned)(R * K + C) * 2u; voffB[i] = (unsigned)(Rb * K + C) * 2u; }
    const size_t kstep = (size_t)(BK * 2);
    const size_t hstep = (size_t)HALF * K * 2;
    const size_t tstep = 2 * hstep;
    const unsigned ldsw = (unsigned)wid * 1024u;
    const int aoff = lds_byte(wr * 64 + fr, fq * 8), boff = lds_byte(wc * 32 + fr, fq * 8);
#define PG8_SA(b, h) (((b) * 2 + (h)) * HTB)
#define PG8_SB(b, h) ((4 + (b) * 2 + (h)) * HTB)
#define PG8_STAGE(bufoff, gbase, voff) do { _Pragma("unroll") for (int _i = 0; _i < 2; ++_i) \
        __builtin_amdgcn_global_load_lds((const unsigned*)((const char*)(gbase) + (voff)[_i]), (PG8_LAS unsigned*)(lds + (bufoff) + ldsw + _i * 8192), 16, 0, 0); } while (0)
#define PG8_LDA(dst, b, h) do { _Pragma("unroll") for (int m = 0; m < 4; ++m) _Pragma("unroll") for (int k = 0; k < 2; ++k) dst[m][k] = *(const PG8_LAS bf16x8*)(lds + PG8_SA(b, h) + aoff + m * 2048 + k * 1024); } while (0)
#define PG8_LDB(dst, b, h) do { _Pragma("unroll") for (int n = 0; n < 2; ++n) _Pragma("unroll") for (int k = 0; k < 2; ++k) dst[n][k] = *(const PG8_LAS bf16x8*)(lds + PG8_SB(b, h) + boff + n * 2048 + k * 1024); } while (0)
#define PG8_MMA(ai, bj, At, Bt) do { __builtin_amdgcn_s_setprio(1); _Pragma("unroll") for (int m = 0; m < 4; ++m) _Pragma("unroll") for (int n = 0; n < 2; ++n) _Pragma("unroll") for (int k = 0; k < 2; ++k) \
        acc[ai][bj][m][n] = __builtin_amdgcn_mfma_f32_16x16x32_bf16(Bt[n][k], At[m][k], acc[ai][bj][m][n], 0, 0, 0); __builtin_amdgcn_s_setprio(0); } while (0)
#define PG8_WAIT_V(n) asm volatile("s_waitcnt vmcnt(" #n ")" ::: "memory")
#define PG8_WAIT_L(n) asm volatile("s_waitcnt lgkmcnt(" #n ")" ::: "memory")
#define PG8_BAR __builtin_amdgcn_s_barrier()
#define PG8_SCHED __builtin_amdgcn_sched_barrier(0)
    Unit cur, nxt; int ui = 0;
    if (!S.next(0, cur)) return;
    f32x4 acc[2][2][4][2];
#pragma unroll
    for (int a = 0; a < 2; ++a)
#pragma unroll
        for (int b = 0; b < 2; ++b)
#pragma unroll
            for (int m = 0; m < 4; ++m)
#pragma unroll
                for (int n = 0; n < 2; ++n) acc[a][b][m][n] = (f32x4){0.f, 0.f, 0.f, 0.f};
    bf16x8 At[4][2], B0[2][2], B1[2][2];
    const char* cA = (const char*)g.A + (size_t)cur.pm * tstep; const char* cB = (const char*)g.Bt + (size_t)cur.pn * tstep;
    S.a_ready(cur);
    if constexpr (SP2) {
        PG8_STAGE(PG8_SB(0, 0), cB, voffB); PG8_STAGE(PG8_SB(0, 1), cB + hstep, voffB); PG8_STAGE(PG8_SA(0, 0), cA, voffA); PG8_STAGE(PG8_SA(0, 1), cA + hstep, voffA);
        if (wr == 1) PG8_BAR;
        PG8_WAIT_V(2); PG8_BAR;
        PG8_STAGE(PG8_SB(1, 0), cB + kstep, voffB); PG8_STAGE(PG8_SA(1, 0), cA + kstep, voffA); PG8_STAGE(PG8_SB(1, 1), cB + hstep + kstep, voffB);
        PG8_WAIT_V(6); PG8_BAR;
    } else {
        PG8_STAGE(PG8_SB(0, 0), cB, voffB); PG8_STAGE(PG8_SA(0, 0), cA, voffA); PG8_STAGE(PG8_SB(0, 1), cB + hstep, voffB); PG8_STAGE(PG8_SA(0, 1), cA + hstep, voffA);
        if (wr == 1) PG8_BAR;
        PG8_WAIT_V(4); PG8_BAR;
        PG8_STAGE(PG8_SB(1, 0), cB + kstep, voffB); PG8_STAGE(PG8_SA(1, 0), cA + kstep, voffA); PG8_STAGE(PG8_SB(1, 1), cB + hstep + kstep, voffB);
        PG8_WAIT_V(6); PG8_BAR;
    }
    for (;;) {
        const bool has_next = S.next(ui + 1, nxt);
        const char* nA = has_next ? (const char*)g.A + (size_t)nxt.pm * tstep : cA; const char* nB = has_next ? (const char*)g.Bt + (size_t)nxt.pn * tstep : cB;
        for (int t = 0; t < nt; t += 2) {
            const bool last = (t == nt - 2);
            const char* a1 = cA + (size_t)(t + 1) * kstep;
            const char* a2 = last ? nA : cA + (size_t)(t + 2) * kstep; const char* b2 = last ? nB : cB + (size_t)(t + 2) * kstep;
            const char* a3 = a2 + kstep; const char* b3 = b2 + kstep;
            if (last && has_next) S.a_ready(nxt);
            if constexpr (SP2) {
            PG8_LDB(B0, 0, 0); PG8_LDB(B1, 0, 1); PG8_SCHED; PG8_LDA(At, 0, 0); PG8_STAGE(PG8_SA(1, 1), a1 + hstep, voffA);
            PG8_WAIT_V(8); PG8_WAIT_L(0); PG8_BAR; PG8_MMA(0, 0, At, B0); PG8_MMA(0, 1, At, B1); PG8_BAR; PG8_SCHED;
            PG8_LDA(At, 0, 1); PG8_STAGE(PG8_SB(0, 0), b2, voffB); PG8_STAGE(PG8_SB(0, 1), b2 + hstep, voffB); PG8_STAGE(PG8_SA(0, 0), a2, voffA);
            PG8_WAIT_V(8); PG8_WAIT_L(0); PG8_BAR; PG8_MMA(1, 0, At, B0); PG8_MMA(1, 1, At, B1); PG8_BAR; PG8_SCHED;
            PG8_LDB(B0, 1, 0); PG8_LDB(B1, 1, 1); PG8_SCHED; PG8_LDA(At, 1, 0); PG8_STAGE(PG8_SA(0, 1), a2 + hstep, voffA);
            PG8_WAIT_V(8); PG8_WAIT_L(0); PG8_BAR; PG8_MMA(0, 0, At, B0); PG8_MMA(0, 1, At, B1); PG8_BAR; PG8_SCHED;
            PG8_LDA(At, 1, 1); PG8_STAGE(PG8_SB(1, 0), b3, voffB); PG8_STAGE(PG8_SB(1, 1), b3 + hstep, voffB); PG8_STAGE(PG8_SA(1, 0), a3, voffA);
            PG8_WAIT_V(8); PG8_WAIT_L(0); PG8_BAR; PG8_MMA(1, 0, At, B0); PG8_MMA(1, 1, At, B1); PG8_BAR; PG8_SCHED;
            } else {
            PG8_LDB(B0, 0, 0); PG8_SCHED; PG8_LDA(At, 0, 0); PG8_STAGE(PG8_SA(1, 1), a1 + hstep, voffA);
            PG8_WAIT_L(8); PG8_BAR; PG8_WAIT_L(0); PG8_MMA(0, 0, At, B0); PG8_BAR; PG8_SCHED;
            PG8_LDB(B1, 0, 1); PG8_STAGE(PG8_SB(0, 0), b2, voffB);
            PG8_BAR; PG8_WAIT_L(0); PG8_MMA(0, 1, At, B1); PG8_BAR;
            PG8_LDA(At, 0, 1); PG8_STAGE(PG8_SA(0, 0), a2, voffA);
            PG8_BAR; PG8_WAIT_L(0); PG8_MMA(1, 0, At, B0); PG8_BAR; PG8_SCHED;
            PG8_STAGE(PG8_SB(0, 1), b2 + hstep, voffB);
            PG8_WAIT_V(6); PG8_BAR; PG8_MMA(1, 1, At, B1); PG8_BAR;
            PG8_LDB(B0, 1, 0); PG8_SCHED; PG8_LDA(At, 1, 0); PG8_STAGE(PG8_SA(0, 1), a2 + hstep, voffA);
            PG8_WAIT_L(8); PG8_BAR; PG8_WAIT_L(0); PG8_MMA(0, 0, At, B0); PG8_BAR; PG8_SCHED;
            PG8_LDB(B1, 1, 1); PG8_STAGE(PG8_SB(1, 0), b3, voffB);
            PG8_BAR; PG8_WAIT_L(0); PG8_MMA(0, 1, At, B1); PG8_BAR;
            PG8_LDA(At, 1, 1); PG8_STAGE(PG8_SA(1, 0), a3, voffA);
            PG8_BAR; PG8_WAIT_L(0); PG8_MMA(1, 0, At, B0); PG8_BAR; PG8_SCHED;
            PG8_STAGE(PG8_SB(1, 1), b3 + hstep, voffB);
            PG8_WAIT_V(6); PG8_BAR; PG8_MMA(1, 1, At, B1); PG8_BAR;
            }
        }
        if constexpr (ALIGN_EPI) { if (wr == 0) PG8_BAR; }
        if constexpr (!Epi::AFTER_DRAIN) { E(acc, cur, wr, wc, fr, fq); S.done(cur); }
        if (!has_next) break;
#pragma unroll
        for (int a = 0; a < 2; ++a)
#pragma unroll
            for (int b = 0; b < 2; ++b)
#pragma unroll
                for (int m = 0; m < 4; ++m)
#pragma unroll
                    for (int n = 0; n < 2; ++n) acc[a][b][m][n] = (f32x4){0.f, 0.f, 0.f, 0.f};
        cur = nxt; cA = nA; cB = nB; ++ui;
        if constexpr (ALIGN_EPI) { if (wr == 1) PG8_BAR; }
    }
    PG8_WAIT_V(0);
    if constexpr (!ALIGN_EPI) { if (wr == 0) PG8_BAR; }
    PG8_BAR;
    if constexpr (Epi::AFTER_DRAIN) { E.fused(acc, cur, wr, wc, fr, fq, lds, wid, lane); S.done(cur); }
#undef PG8_SA
#undef PG8_SB
#undef PG8_STAGE
#undef PG8_LDA
#undef PG8_LDB
#undef PG8_MMA
#undef PG8_WAIT_V
#undef PG8_WAIT_L
#undef PG8_BAR
#undef PG8_SCHED
}
}

#define GAS __attribute__((address_space(1)))
#define LAS __attribute__((address_space(3)))
typedef unsigned short bf16;
typedef unsigned v4u __attribute__((ext_vector_type(4)));
typedef float f32x4 __attribute__((ext_vector_type(4)));
typedef short bf16x8 __attribute__((ext_vector_type(8)));
typedef GAS unsigned gu32;
typedef GAS unsigned long long gu64;
#define RLX_AGENT __ATOMIC_RELAXED, __HIP_MEMORY_SCOPE_AGENT
#define LDS_WAIT() asm volatile("s_waitcnt lgkmcnt(0)" ::: "memory")
#define VM_WAIT() asm volatile("s_waitcnt vmcnt(0)" ::: "memory")
__device__ __forceinline__ unsigned long long rt() { return __builtin_amdgcn_s_memrealtime(); }
__device__ __forceinline__ unsigned f2bf(float f) { unsigned u = __builtin_bit_cast(unsigned, f); return (u + 0x7fffu + ((u >> 16) & 1u)) >> 16; }
__device__ __forceinline__ unsigned pk2(float lo, float hi) { return f2bf(lo) | (f2bf(hi) << 16); }
#define XB_TMO      128
#define XB_XCNT(j)  (256  + 64 * (j))
#define XB_XSUB(j)  (1280 + 64 * (j))
#define XB_XGEN(j)  (2304 + 64 * (j))
#define XB_TOP      3328
#define XB_TOPGEN   3392
#define XCD_BAR_WORDS 3456
#define XB_SPIN_CAP (1u << 18)

__device__ __forceinline__ unsigned xb_ld(unsigned* p)              { return __hip_atomic_load(p, __ATOMIC_RELAXED, __HIP_MEMORY_SCOPE_AGENT); }
__device__ __forceinline__ unsigned xb_add(unsigned* p, unsigned v) { return __hip_atomic_fetch_add(p, v, __ATOMIC_RELAXED, __HIP_MEMORY_SCOPE_AGENT); }
__device__ __forceinline__ unsigned xb_xcc_id() { return (unsigned)__builtin_amdgcn_s_getreg((3 << 11) | 20) & 0xFu; }
#define XB_SPIN(cond, bar) do { unsigned _sp = 0; while (cond) { __builtin_amdgcn_s_sleep(1); \
    if ((++_sp & 255u) == 0u) { if (xb_ld(&(bar)[XB_TMO])) break; if (_sp > XB_SPIN_CAP) { atomicAdd(&(bar)[XB_TMO], 1u); break; } } } } while (0)

struct XcdBarrier {
    unsigned* bar; unsigned x;
    volatile LAS unsigned* st;
};

__device__ __forceinline__ XcdBarrier xcd_barrier_post(unsigned* bar, volatile LAS unsigned* st) {
    XcdBarrier b; b.bar = bar; b.x = xb_xcc_id(); b.st = st;
    if (threadIdx.x == 0) (void)xb_add(&bar[XB_XCNT(b.x)], 1u);
    return b;
}
__device__ __forceinline__ void xcd_barrier_complete(unsigned* bar, unsigned x, unsigned& nloc, unsigned& nx) {
    const unsigned G = gridDim.x * gridDim.y * gridDim.z;
    unsigned sum, cnt, mine, sp = 0u;
    for (;;) {
        sum = 0u; cnt = 0u; mine = 0u;
#pragma unroll
        for (unsigned j = 0; j < 16; ++j) { const unsigned c = xb_ld(&bar[XB_XCNT(j)]); sum += c; cnt += (c > 0u) ? 1u : 0u; mine = (j == x) ? c : mine; }
        if (sum == G) break;
        __builtin_amdgcn_s_sleep(1);
        if ((++sp & 255u) == 0u) { if (xb_ld(&bar[XB_TMO])) break; if (sp > XB_SPIN_CAP) { atomicAdd(&bar[XB_TMO], 1u); break; } }
    }
    nloc = mine > 0u ? mine : 1u; nx = cnt > 0u ? cnt : 1u;
}

__device__ __forceinline__ void xcd_barrier(const XcdBarrier& b) {
    asm volatile("s_waitcnt vmcnt(0)" ::: "memory");
    __syncthreads();
    if (threadIdx.x == 0) {
        unsigned* bar = b.bar;
        __builtin_amdgcn_s_waitcnt(0);
        unsigned nloc = b.st[0], nx = b.st[1];
        if (nloc == 0u) { xcd_barrier_complete(bar, b.x, nloc, nx); b.st[0] = nloc; b.st[1] = nx; }
        const unsigned old = xb_add(&bar[XB_XSUB(b.x)], 1u);
        const unsigned gen = old / nloc;
        if (old + 1u == (gen + 1u) * nloc) {
            __builtin_amdgcn_fence(__ATOMIC_RELEASE, "agent");
            asm volatile("s_waitcnt vmcnt(0)" ::: "memory");
            const unsigned og = xb_add(&bar[XB_TOP], 1u);
            const unsigned tg = og / nx;
            if (og + 1u == (tg + 1u) * nx) xb_add(&bar[XB_TOPGEN], 1u);
            else XB_SPIN(xb_ld(&bar[XB_TOPGEN]) == tg, bar);
            __builtin_amdgcn_fence(__ATOMIC_ACQUIRE, "agent");
            xb_add(&bar[XB_XGEN(b.x)], 1u);
            asm volatile("s_waitcnt vmcnt(0)" ::: "memory");
        } else {
            XB_SPIN(xb_ld(&bar[XB_XGEN(b.x)]) == gen, bar);
            __builtin_amdgcn_fence(__ATOMIC_ACQUIRE, "agent");
            asm volatile("s_waitcnt vmcnt(0)" ::: "memory");
        }
    }
    __syncthreads();
}

constexpr size_t MiB = 1u << 20;
constexpr size_t WS_CTL = 0, CTL_ZERO_BYTES = 1 * MiB;
constexpr size_t WS_COS = 1 * MiB, WS_SIN = 5 * MiB;
constexpr size_t WS_MODS = 9 * MiB;
constexpr size_t WS_KVMOD = 9 * MiB + 256 * 1024;
constexpr size_t WS_SCQ = 9 * MiB + 320 * 1024, WS_SCK = WS_SCQ + 4096, WS_SCG = WS_SCQ + 8192;
constexpr size_t WS_BIAS = 9 * MiB + 384 * 1024;
constexpr size_t WS_WT_IN = 10 * MiB, WS_WT_OUT = 22 * MiB, WS_WT_UP = 26 * MiB, WS_WT_DOWN = 37 * MiB, WS_WT_KV = 43 * MiB;
constexpr size_t WS_KSH = 44 * MiB, WS_VSH = 52 * MiB;
constexpr size_t WS_R = 60 * MiB;
constexpr size_t WS_BIG = 188 * MiB;
constexpr size_t WS_END = 380 * MiB;
constexpr int CW_TMO = 0, CW_BAR = 4096;

constexpr int RING_OFF = 0, RING_BYTES = 131072;
constexpr int LDSCTL_OFF = 143360, MISC_OFF = LDSCTL_OFF + 320;
constexpr int LDS_BYTES = 147456;
constexpr int NWAVES = 8;

__constant__ unsigned char T5_BUCKET[128] = {0, 1, 2, 3, 4, 5, 6, 7, 8, 9, 10, 11, 12, 13, 14, 15, 16, 16, 16, 17, 17, 18, 18, 18, 19, 19, 19, 20, 20, 20, 20, 21, 21, 21, 21, 22, 22, 22, 22, 22, 23, 23, 23, 23, 23, 23, 24, 24, 24, 24, 24, 24, 25, 25, 25, 25, 25, 25, 25, 26, 26, 26, 26, 26, 26, 26, 26, 27, 27, 27, 27, 27, 27, 27, 27, 27, 27, 28, 28, 28, 28, 28, 28, 28, 28, 28, 28, 29, 29, 29, 29, 29, 29, 29, 29, 29, 29, 29, 29, 30, 30, 30, 30, 30, 30, 30, 30, 30, 30, 30, 30, 30, 30, 31, 31, 31, 31, 31, 31, 31, 31, 31, 31, 31, 31, 31, 31, 31};

struct Frame {
    LAS unsigned char* lds;
    volatile LAS unsigned* MISC;
    gu32* ctl;
    int tid, lane, wave, vcu, G, dry;
    unsigned char* ws;
    const float* __attribute__((address_space(4)))* in;
    float* out;
};
enum { I_X = 0, I_C, I_NORMG, I_ADAW, I_ADAB, I_RWIN, I_RWOUT, I_KVNG, I_KVADAW, I_KVADAB, I_KVW, I_SWQ, I_SWO, I_SINKS, I_RELB, I_WUP, I_CONVW, I_CONVB, I_WDOWN };

__device__ __forceinline__ void launder_ids(Frame& F) { int t = threadIdx.x; asm volatile("" : "+v"(t)); F.tid = t; F.lane = t & 63; F.wave = __builtin_amdgcn_readfirstlane(t >> 6); }
__device__ __forceinline__ float bf2f(bf16 h) { return __uint_as_float(((unsigned)h) << 16); }
__device__ __forceinline__ float wave_sum(float v) {
#pragma unroll
    for (int o = 1; o < 64; o <<= 1) v += __shfl_xor(v, o);
    return v;
}
__device__ __forceinline__ float wave_max(float v) {
#pragma unroll
    for (int o = 1; o < 64; o <<= 1) v = fmaxf(v, __shfl_xor(v, o));
    return v;
}
__device__ __forceinline__ float dot8(const v4u a, const v4u b) {
    float s = 0.f;
#pragma unroll
    for (int e = 0; e < 4; ++e) { s += __uint_as_float(a[e] << 16) * __uint_as_float(b[e] << 16); s += __uint_as_float(a[e] & 0xffff0000u) * __uint_as_float(b[e] & 0xffff0000u); }
    return s;
}
__device__ __forceinline__ float silu(float x) { return x * __builtin_amdgcn_rcpf(1.0f + __expf(-x)); }

__device__ __forceinline__ void phase_mods(Frame& F) {
    launder_ids(F);
    LAS float* cact = (LAS float*)(F.lds);
    LAS float* part = (LAS float*)(F.lds + 8192);
    for (int i = F.tid; i < 2 * D; i += 512) cact[i] = silu(F.in[I_C][i]);
    __syncthreads();
    const int item = F.vcu;
    const float* W = nullptr; const float* bias = nullptr; float* outp = nullptr; int N = 0, ostride = 0;
    if (item < 208) {
        const int col0 = item * 128;
        if (col0 < 4 * 6144) { const int l = col0 / 6144, cl = col0 % 6144; W = F.in[I_ADAW] + (size_t)l * D * 6144 + cl; N = 6144; bias = F.in[I_ADAB] + l * 6144 + cl; outp = (float*)(F.ws + WS_MODS) + l * 2 * 6144 + cl; ostride = 6144; }
        else { const int cl = col0 - 4 * 6144; W = F.in[I_KVADAW] + cl; N = 2048; bias = F.in[I_KVADAB] + cl; outp = (float*)(F.ws + WS_KVMOD) + cl; ostride = 2048; }
        const int cg = F.wave & 1, kq = F.wave >> 1, col = 64 * cg + F.lane, k0 = kq * 256;
        float a0 = 0.f, a1 = 0.f;
#pragma unroll 8
        for (int k = k0; k < k0 + 256; ++k) { const float w = W[(size_t)k * N + col]; a0 += w * cact[k]; a1 += w * cact[D + k]; }
        part[(F.wave * 2 + 0) * 64 + F.lane] = a0; part[(F.wave * 2 + 1) * 64 + F.lane] = a1;
    }
    __syncthreads();
    if (item < 208 && F.tid < 256) {
        const int b = F.tid >> 7, col = F.tid & 127, cg = col >> 6, ln = col & 63; float s = 0.f;
#pragma unroll
        for (int kq = 0; kq < 4; ++kq) s += part[(((kq << 1) | cg) * 2 + b) * 64 + ln];
        outp[b * ostride + col] = s + bias[col];
    }
    __syncthreads();
}
__device__ __forceinline__ void sincos_d(double a, double& s, double& c) {
    const double k = __builtin_rint(a * 0.6366197723675814);
    double r = __builtin_fma(-k, 1.5707963267948966, a); r = __builtin_fma(-k, 6.123233995736766e-17, r);
    const double r2 = r * r;
    double sp = 1.0 / 6227020800.0; sp = sp * r2 - 1.0 / 39916800.0; sp = sp * r2 + 1.0 / 362880.0; sp = sp * r2 - 1.0 / 5040.0; sp = sp * r2 + 1.0 / 120.0; sp = sp * r2 - 1.0 / 6.0; sp = r + r * r2 * sp;
    double cp = -1.0 / 87178291200.0; cp = cp * r2 + 1.0 / 479001600.0; cp = cp * r2 - 1.0 / 3628800.0; cp = cp * r2 + 1.0 / 40320.0; cp = cp * r2 - 1.0 / 720.0; cp = cp * r2 + 1.0 / 24.0; cp = cp * r2 - 0.5; cp = 1.0 + r2 * cp;
    const int q = ((int)k) & 3;
    s = (q == 0) ? sp : (q == 1) ? cp : (q == 2) ? -sp : -cp;
    c = (q == 0) ? cp : (q == 1) ? -sp : (q == 2) ? -cp : sp;
}
__device__ __forceinline__ void phase_tables(Frame& F) {
    launder_ids(F);
    float* cosT = (float*)(F.ws + WS_COS); float* sinT = (float*)(F.ws + WS_SIN);
    const int NT = F.G * 512;
    for (int idx = F.vcu * 512 + F.tid; idx < SEQ * 128; idx += NT) {
        const int pos = idx >> 7, i = idx & 127;
        double inv = 1.0, r = 0.930572040929699;
#pragma unroll
        for (int bit = 0; bit < 7; ++bit) { if ((i >> bit) & 1) inv *= r; r *= r; }
        double s, c; sincos_d((double)pos * inv, s, c);
        cosT[idx] = (float)c; sinT[idx] = (float)s;
    }
    if (F.vcu == F.G - 1) {
        float* scq = (float*)(F.ws + WS_SCQ); float* sck = (float*)(F.ws + WS_SCK); float* scg = (float*)(F.ws + WS_SCG); float* bias = (float*)(F.ws + WS_BIAS);
        { const int h = F.tid >> 7, p = F.tid & 127; double gam = 1.0 - 1.0 / (double)(32 << h), g = 1.0;
          for (int e = 0; e <= p; ++e) g *= gam;
          scq[F.tid] = (float)g; sck[F.tid] = (float)(0.0625 / g);
          if (p == 127) scg[h] = (float)g; }
        for (int idx = F.tid; idx < 16 * 128; idx += 512) { const int head = idx >> 7, dist = idx & 127; bias[idx] = F.in[I_RELB][(int)T5_BUCKET[dist] * 16 + head]; }
    }
}
__device__ __forceinline__ void transpose_item(const float* W, int K, int N, bf16* WT, LAS float* scr, int item, int lane, int mode) {
    const int nblk = N / 32, kb = item / nblk, nb = item % nblk, k0 = 64 * kb, n0 = 32 * nb;
    int r0 = n0; bool vperm = false; if (mode == 1) { r0 = n0 < 2048 ? n0 : (n0 < 4096 ? n0 + 2048 : n0 - 2048); vperm = (n0 >= 2048 && n0 < 4096); }
#pragma unroll 8
    for (int i = 0; i < 32; ++i) { const int kk = 2 * i + (lane >> 5); scr[kk * 33 + (lane & 31)] = W[(size_t)(k0 + kk) * N + n0 + (lane & 31)]; }
    LDS_WAIT(); asm volatile("" ::: "memory");
    const int c = lane & 7;
#pragma unroll
    for (int j = 0; j < 4; ++j) { const int n = (lane >> 3) + 8 * j; const LAS float* s = scr + (8 * c) * 33 + n;
        v4u o; o.x = pk2(s[0 * 33], s[1 * 33]); o.y = pk2(s[2 * 33], s[3 * 33]); o.z = pk2(s[4 * 33], s[5 * 33]); o.w = pk2(s[6 * 33], s[7 * 33]);
        const int nr = vperm ? (16 * ((n >> 2) & 1) + 4 * (n >> 3) + (n & 3)) : n;
        *(GAS v4u*)(WT + (size_t)(r0 + nr) * K + k0 + 8 * c) = o; }
    LDS_WAIT(); asm volatile("" ::: "memory");
}
__device__ __forceinline__ void phase_weights(Frame& F, int layer) {
    launder_ids(F);
    LAS float* scr = (LAS float*)(F.lds + RING_OFF + F.wave * 16384);
    const int gw = F.vcu * NWAVES + F.wave, NGW = F.G * NWAVES;
    const bool ret = layer < 2; const int li = ret ? layer : layer - 2;
    const float* w0 = ret ? F.in[I_RWIN] + (size_t)li * D * RETN : F.in[I_SWQ] + (size_t)li * D * D;        const int K0 = D, N0 = ret ? RETN : D;
    const float* w1 = ret ? F.in[I_RWOUT] + (size_t)li * 2048 * D : F.in[I_SWO] + (size_t)li * D * D;       const int K1 = ret ? 2048 : D, N1 = D;
    const float* w2 = F.in[I_WUP] + (size_t)layer * D * FF2;   const int K2 = D, N2 = FF2;
    const float* w3 = F.in[I_WDOWN] + (size_t)layer * FF * D;  const int K3 = FF, N3 = D;
    const int i0 = (K0 / 64) * (N0 / 32), i1 = (K1 / 64) * (N1 / 32), i2 = (K2 / 64) * (N2 / 32), i3 = (K3 / 64) * (N3 / 32), i4 = (layer == 2) ? (D / 64) * (512 / 32) : 0;
    const int total = i0 + i1 + i2 + i3 + i4;
    for (int it = gw; it < total; it += NGW) {
        int r = it;
        if (r < i0) { transpose_item(w0, K0, N0, (bf16*)(F.ws + WS_WT_IN), scr, r, F.lane, ret ? 1 : 0); continue; } r -= i0;
        if (r < i1) { transpose_item(w1, K1, N1, (bf16*)(F.ws + WS_WT_OUT), scr, r, F.lane, 0); continue; } r -= i1;
        if (r < i2) { transpose_item(w2, K2, N2, (bf16*)(F.ws + WS_WT_UP), scr, r, F.lane, 0); continue; } r -= i2;
        if (r < i3) { transpose_item(w3, K3, N3, (bf16*)(F.ws + WS_WT_DOWN), scr, r, F.lane, 0); continue; } r -= i3;
        transpose_item(F.in[I_KVW], D, 512, (bf16*)(F.ws + WS_WT_KV), scr, r, F.lane, 0);
    }
}

struct RowPass {
    const float* xsrc; float* xdst; const bf16* y; const float* gpost; const float* gate; int gstride;
    bf16* h1; const float* g1; const float* sc1; const float* sh1; int st1;
    bf16* h2; const float* g2; const float* sc2; const float* sh2; int st2;
};
__device__ __forceinline__ void phase_rowpass(Frame& F, const RowPass& P) {
    launder_ids(F);
    const int gw = F.vcu * NWAVES + F.wave, NGW = F.G * NWAVES;
    const int c0 = 4 * F.lane;
    for (int bb = 0; bb < BATCH; ++bb) {
        f32x4 cA[4], cB1[4], cC1[4], cB2[4], cC2[4];
#pragma unroll
        for (int j = 0; j < 4; ++j) {
            const int c = c0 + 256 * j;
            if (P.y) { const f32x4 g = *(const f32x4*)(P.gpost + c), t = *(const f32x4*)(P.gate + bb * P.gstride + c); cA[j] = g * (t + 1.0f); } else cA[j] = (f32x4){0.f, 0.f, 0.f, 0.f};
            if (P.h1) { const f32x4 g = *(const f32x4*)(P.g1 + c), s = *(const f32x4*)(P.sc1 + bb * P.st1 + c); cB1[j] = g * (s + 1.0f); cC1[j] = *(const f32x4*)(P.sh1 + bb * P.st1 + c); } else { cB1[j] = (f32x4){0.f, 0.f, 0.f, 0.f}; cC1[j] = cB1[j]; }
            if (P.h2) { const f32x4 g = *(const f32x4*)(P.g2 + c), s = *(const f32x4*)(P.sc2 + bb * P.st2 + c); cB2[j] = g * (s + 1.0f); cC2[j] = *(const f32x4*)(P.sh2 + bb * P.st2 + c); } else { cB2[j] = (f32x4){0.f, 0.f, 0.f, 0.f}; cC2[j] = cB2[j]; }
        }
        for (int m = bb * SEQ + gw; m < (bb + 1) * SEQ; m += NGW) {
            f32x4 x[4];
#pragma unroll
            for (int j = 0; j < 4; ++j) x[j] = *(const f32x4*)(P.xsrc + (size_t)m * D + c0 + 256 * j);
            if (P.y) {
                f32x4 yv[4]; float ss = 0.f;
#pragma unroll
                for (int j = 0; j < 4; ++j) { const uint2 w = *(const uint2*)(P.y + (size_t)m * D + c0 + 256 * j);
                    yv[j] = (f32x4){__uint_as_float(w.x << 16), __uint_as_float(w.x & 0xffff0000u), __uint_as_float(w.y << 16), __uint_as_float(w.y & 0xffff0000u)};
                    ss += (yv[j][0] * yv[j][0] + yv[j][1] * yv[j][1]) + (yv[j][2] * yv[j][2] + yv[j][3] * yv[j][3]); }
                const float rstd = __builtin_amdgcn_rsqf(wave_sum(ss) * (1.0f / D) + NORM_EPS);
#pragma unroll
                for (int j = 0; j < 4; ++j) x[j] = x[j] + cA[j] * yv[j] * rstd;
            }
            if (P.xdst) {
#pragma unroll
                for (int j = 0; j < 4; ++j) *(f32x4*)(P.xdst + (size_t)m * D + c0 + 256 * j) = x[j];
            }
            if (P.h1 || P.h2) {
                float ss = 0.f;
#pragma unroll
                for (int j = 0; j < 4; ++j) ss += (x[j][0] * x[j][0] + x[j][1] * x[j][1]) + (x[j][2] * x[j][2] + x[j][3] * x[j][3]);
                const float rstd = __builtin_amdgcn_rsqf(wave_sum(ss) * (1.0f / D) + NORM_EPS);
                if (P.h1) {
#pragma unroll
                    for (int j = 0; j < 4; ++j) { const f32x4 h = x[j] * rstd * cB1[j] + cC1[j]; uint2 w; w.x = pk2(h[0], h[1]); w.y = pk2(h[2], h[3]); *(uint2*)(P.h1 + (size_t)m * D + c0 + 256 * j) = w; }
                }
                if (P.h2) {
#pragma unroll
                    for (int j = 0; j < 4; ++j) { const f32x4 h = x[j] * rstd * cB2[j] + cC2[j]; uint2 w; w.x = pk2(h[0], h[1]); w.y = pk2(h[2], h[3]); *(uint2*)(P.h2 + (size_t)m * D + c0 + 256 * j) = w; }
                }
            }
        }
    }
}

__device__ __forceinline__ void phase_conv(Frame& F, int layer) {
    launder_ids(F);
    const bf16* U = (const bf16*)(F.ws + WS_BIG); bf16* A = (bf16*)(F.ws + WS_R);
    const float* cw = F.in[I_CONVW] + (size_t)layer * 3 * FF2; const float* cb = F.in[I_CONVB] + (size_t)layer * FF2;
    const int gw = F.vcu * NWAVES + F.wave, NGW = F.G * NWAVES;
    constexpr int NSEG = M / 16, NHT = NSEG * 11, NWT = NHT / 2;
    for (int wt = gw; wt < NWT; wt += NGW) {
        const int ht = 2 * wt + (F.lane >> 5), cgb = ht % 11, seg = ht / 11, c0 = (cgb * 32 + (F.lane & 31)) * 8, m0 = seg * 16;
        f32x4 wg[3][2], wv[3][2], bg[2], bv[2];
#pragma unroll
        for (int h = 0; h < 2; ++h) {
#pragma unroll
            for (int j = 0; j < 3; ++j) { wg[j][h] = *(const f32x4*)(cw + j * FF2 + c0 + 4 * h); wv[j][h] = *(const f32x4*)(cw + j * FF2 + FF + c0 + 4 * h); }
            bg[h] = *(const f32x4*)(cb + c0 + 4 * h); bv[h] = *(const f32x4*)(cb + FF + c0 + 4 * h);
        }
        v4u g1, g2, v1, v2;
        if ((m0 & (SEQ - 1)) == 0) { g1 = g2 = v1 = v2 = (v4u){0u, 0u, 0u, 0u}; }
        else { g1 = *(const v4u*)(U + (size_t)(m0 - 1) * FF2 + c0); v1 = *(const v4u*)(U + (size_t)(m0 - 1) * FF2 + FF + c0); g2 = *(const v4u*)(U + (size_t)(m0 - 2) * FF2 + c0); v2 = *(const v4u*)(U + (size_t)(m0 - 2) * FF2 + FF + c0); }
#pragma unroll 4
        for (int r = 0; r < 16; ++r) {
            const int m = m0 + r;
            const v4u g0 = *(const v4u*)(U + (size_t)m * FF2 + c0), v0 = *(const v4u*)(U + (size_t)m * FF2 + FF + c0);
            v4u o;
#pragma unroll
            for (int e = 0; e < 4; ++e) {
                const int h = e >> 1, q = (e & 1) * 2;
                const float ga = bg[h][q] + wg[0][h][q] * __uint_as_float(g2[e] << 16) + wg[1][h][q] * __uint_as_float(g1[e] << 16) + wg[2][h][q] * __uint_as_float(g0[e] << 16);
                const float gb = bg[h][q + 1] + wg[0][h][q + 1] * __uint_as_float(g2[e] & 0xffff0000u) + wg[1][h][q + 1] * __uint_as_float(g1[e] & 0xffff0000u) + wg[2][h][q + 1] * __uint_as_float(g0[e] & 0xffff0000u);
                const float va = bv[h][q] + wv[0][h][q] * __uint_as_float(v2[e] << 16) + wv[1][h][q] * __uint_as_float(v1[e] << 16) + wv[2][h][q] * __uint_as_float(v0[e] << 16);
                const float vb = bv[h][q + 1] + wv[0][h][q + 1] * __uint_as_float(v2[e] & 0xffff0000u) + wv[1][h][q + 1] * __uint_as_float(v1[e] & 0xffff0000u) + wv[2][h][q + 1] * __uint_as_float(v0[e] & 0xffff0000u);
                o[e] = pk2(silu(ga) * va, silu(gb) * vb);
            }
            *(v4u*)(A + (size_t)m * FF + c0) = o;
            g2 = g1; g1 = g0; v2 = v1; v1 = v0;
        }
    }
}


typedef short v4i16_t __attribute__((ext_vector_type(4)));
typedef unsigned v2u __attribute__((ext_vector_type(2)));
#define MFMA16(a, b, c) __builtin_amdgcn_mfma_f32_16x16x32_bf16((a), (b), (c), 0, 0, 0)
__device__ __forceinline__ unsigned pk2h(float lo, float hi) { unsigned r; asm volatile("v_cvt_pk_bf16_f32 %0, %1, %2" : "=v"(r) : "v"(lo), "v"(hi)); return r; }

__device__ __forceinline__ void pass1_f(Frame& F) {
    launder_ids(F);
    const bf16* KF = (const bf16*)(F.ws + WS_BIG + 32 * MiB); const bf16* VF = (const bf16*)(F.ws + WS_BIG + 64 * MiB); bf16* RF = (bf16*)(F.ws + WS_R);
    const int bh = F.vcu >> 5, blk = F.vcu & 31, dkb = blk & 3, dvb = blk >> 2, b = bh >> 2, h = bh & 3;
    const float gch = ((const float*)(F.ws + WS_SCG))[h];
    constexpr int KTILE = 16384;
    const int tid = F.tid, lane = F.lane, g = lane >> 4, pair = F.wave & 1, nt = F.wave >> 1;
    const bf16* kg[2]; int kl[2]; bool ksw[2];
#pragma unroll
    for (int i = 0; i < 2; ++i) {
        const int u = tid + 512 * i, jt = u >> 7, ktl = (u >> 6) & 1, gg = (u >> 4) & 3, r = u & 15, j = 16 * jt + r, cc = 4 * ktl + gg;
        kg[i] = KF + ((size_t)((b * 64) * 4 + h) * 32768) + (size_t)((jt * 8 + 2 * dkb) * 512) + (u & 127) * 8;
        kl[i] = j * 128 + ((cc ^ (((j >> 3) & 1) << 2)) << 4); ksw[i] = (j >> 1) & 1;
    }
    const bf16* vgp = VF + ((size_t)(bh * 64) * 65536) + (size_t)(((4 * dvb + nt) * 4) * 512) + lane * 8;
    const int q4 = (lane >> 2) & 3, p4 = lane & 3;
    int aoff[2][2];
#pragma unroll
    for (int s = 0; s < 2; ++s)
#pragma unroll
        for (int t = 0; t < 2; ++t) { const int row = 8 * g + 4 * s + q4; const int unit = (pair * 8 + 2 * p4 + t) ^ ((row >> 1) & 1) ^ (((row >> 3) & 1) << 3); aoff[s][t] = row * 128 + unit * 8; }
    bf16* rdst = RF + ((size_t)(bh * 64) * 131072) + (size_t)(((4 * dvb + nt) * 8 + 2 * dkb + pair) * 512) + lane * 8;
    f32x4 acc0 = {0.f, 0.f, 0.f, 0.f}, acc1 = {0.f, 0.f, 0.f, 0.f};
    v4u ka[2], kb[2]; bf16x8 va[4], vb[4];
#define P1_LOAD(n, rk, rv) do { _Pragma("unroll") for (int i_ = 0; i_ < 2; ++i_) rk[i_] = *(const v4u*)(kg[i_] + (size_t)(n) * 4 * 32768); \
                                 _Pragma("unroll") for (int i_ = 0; i_ < 4; ++i_) rv[i_] = *(const bf16x8*)(vgp + (size_t)(n) * 65536 + i_ * 512); } while (0)
#define P1_WRITE(rk, bufo) do { _Pragma("unroll") for (int i_ = 0; i_ < 2; ++i_) { v4u w_ = rk[i_]; if (ksw[i_]) w_ = (v4u){w_.z, w_.w, w_.x, w_.y}; *(LAS v4u*)(F.lds + (bufo) + kl[i_]) = w_; } } while (0)
#define P1_STEP(n, bufo, rkcur, rvcur, rknext) do { \
        { v4u w_; w_.x = pk2h(acc0[0], acc0[1]); w_.y = pk2h(acc0[2], acc0[3]); w_.z = pk2h(acc1[0], acc1[1]); w_.w = pk2h(acc1[2], acc1[3]); *(v4u*)(rdst + (size_t)(n) * 131072) = w_; } \
        if ((n) <= NCH - 2) { \
            _Pragma("unroll") for (int ks_ = 0; ks_ < 4; ++ks_) { \
                const LAS unsigned char* kb_ = F.lds + (bufo) + ks_ * 4096; \
                const v4i16_t x00 = __builtin_amdgcn_ds_read_tr16_b64_v4i16((LAS v4i16_t*)(kb_ + aoff[0][0])), x10 = __builtin_amdgcn_ds_read_tr16_b64_v4i16((LAS v4i16_t*)(kb_ + aoff[1][0])); \
                const v4i16_t x01 = __builtin_amdgcn_ds_read_tr16_b64_v4i16((LAS v4i16_t*)(kb_ + aoff[0][1])), x11 = __builtin_amdgcn_ds_read_tr16_b64_v4i16((LAS v4i16_t*)(kb_ + aoff[1][1])); \
                const bf16x8 a0_ = {x00[0], x00[1], x00[2], x00[3], x10[0], x10[1], x10[2], x10[3]}, a1_ = {x01[0], x01[1], x01[2], x01[3], x11[0], x11[1], x11[2], x11[3]}; \
                acc0 = MFMA16(a0_, rvcur[ks_], acc0); acc1 = MFMA16(a1_, rvcur[ks_], acc1); } \
            acc0 = acc0 * gch; acc1 = acc1 * gch; } \
        if ((n) + 2 <= NCH - 2) P1_LOAD((n) + 2, rkcur, rvcur); \
        if ((n) + 1 <= NCH - 2) P1_WRITE(rknext, ((bufo) == 0 ? KTILE : 0)); \
        __syncthreads(); } while (0)
    P1_LOAD(0, ka, va); P1_LOAD(1, kb, vb);
    P1_WRITE(ka, 0);
    __syncthreads();
    for (int n = 0; n < NCH; n += 2) { P1_STEP(n, 0, ka, va, kb); P1_STEP(n + 1, KTILE, kb, vb, ka); }
#undef P1_LOAD
#undef P1_WRITE
#undef P1_STEP
}

template <int DV> __device__ __forceinline__ void pass2_f(Frame& F) {
    launder_ids(F);
    const bf16* QF = (const bf16*)(F.ws + WS_BIG); const bf16* KF = (const bf16*)(F.ws + WS_BIG + 32 * MiB); const bf16* VF = (const bf16*)(F.ws + WS_BIG + 64 * MiB);
    const bf16* GF = (const bf16*)(F.ws + WS_BIG + 128 * MiB); const bf16* RF = (const bf16*)(F.ws + WS_R);
    bf16* O = (bf16*)(F.ws + WS_BIG + 128 * MiB);
    constexpr int PSTR = 272;
    LAS unsigned char* Pl = F.lds; LAS float* st = (LAS float*)(F.lds + 36864);
    const int lane = F.lane, c = lane & 15, g = lane >> 4, wr = F.wave >> 2, wc = F.wave & 3;
    for (int it = F.vcu; it < 512; it += F.G) {
        const int bh = (it & 255) >> 5, n = (it & 31) + 32 * (it >> 8), b = bh >> 2, h = bh & 3;
        const bf16* q = QF + ((size_t)((b * 64 + n) * 4 + h) * 32768) + lane * 8; const bf16* k = KF + ((size_t)((b * 64 + n) * 4 + h) * 32768) + lane * 8;
        const bf16* vt = VF + ((size_t)(bh * 64 + n) * 65536) + lane * 8; const bf16* rt = RF + ((size_t)(bh * 64 + n) * 131072) + lane * 8;
        const bf16* qb = q + (size_t)(4 * wr) * 8 * 512;
        if (!(wr == 0 && wc >= 2) && !(DV & 2)) {
            f32x4 s[2][4];
#pragma unroll
            for (int t = 0; t < 2; ++t)
#pragma unroll
                for (int mi = 0; mi < 4; ++mi) s[t][mi] = (f32x4){0.f, 0.f, 0.f, 0.f};
            const bf16* ka = k + (size_t)(2 * wc) * 8 * 512;
            bf16x8 a0[2], b0[4], a1[2], b1[4];
#define S_LOAD(ks_, a_, b_) do { _Pragma("unroll") for (int t = 0; t < 2; ++t) a_[t] = *(const bf16x8*)(ka + (size_t)(t * 8 + (ks_)) * 512); \
                                 _Pragma("unroll") for (int mi = 0; mi < 4; ++mi) b_[mi] = *(const bf16x8*)(qb + (size_t)(mi * 8 + (ks_)) * 512); } while (0)
#define S_MMA(a_, b_) do { _Pragma("unroll") for (int t = 0; t < 2; ++t) _Pragma("unroll") for (int mi = 0; mi < 4; ++mi) s[t][mi] = MFMA16(a_[t], b_[mi], s[t][mi]); } while (0)
            S_LOAD(0, a0, b0);
#pragma unroll
            for (int ks = 0; ks < 8; ks += 2) { S_LOAD(ks + 1, a1, b1); S_MMA(a0, b0); if (ks + 2 < 8) S_LOAD(ks + 2, a0, b0); S_MMA(a1, b1); }
#undef S_LOAD
#undef S_MMA
#pragma unroll
            for (int t = 0; t < 2; ++t)
#pragma unroll
                for (int mi = 0; mi < 4; ++mi) {
                    const int i = 64 * wr + 16 * mi + c, j0 = 32 * wc + 16 * t + 4 * g;
                    const float v0 = (j0 + 0 <= i) ? s[t][mi][0] : 0.f, v1 = (j0 + 1 <= i) ? s[t][mi][1] : 0.f, v2 = (j0 + 2 <= i) ? s[t][mi][2] : 0.f, v3 = (j0 + 3 <= i) ? s[t][mi][3] : 0.f;
                    v2u w; w.x = pk2h(v0, v1); w.y = pk2h(v2, v3);
                    *(LAS v2u*)(Pl + i * PSTR + j0 * 2) = w;
                }
        }
        const bf16* va = vt + (size_t)(8 * wc) * 4 * 512; const bf16* ra = rt + (size_t)(8 * wc) * 8 * 512;
        const LAS unsigned char* pb = Pl + (64 * wr + c) * PSTR + 16 * g;
        const int nks = (DV & 4) ? 0 : (wr == 0 ? 2 : 4), nst = nks + ((DV & 8) ? 0 : 8);
        bf16x8 fa[8], fb[8];
#define O_LOADA(st_, a_) do { if ((st_) < nks) { _Pragma("unroll") for (int ni = 0; ni < 8; ++ni) a_[ni] = *(const bf16x8*)(va + (size_t)(ni * 4 + (st_)) * 512); } \
                              else { _Pragma("unroll") for (int ni = 0; ni < 8; ++ni) a_[ni] = *(const bf16x8*)(ra + (size_t)(ni * 8 + ((st_) - nks)) * 512); } } while (0)
        O_LOADA(0, fa);
        __syncthreads();
        f32x4 acc[4][8];
#pragma unroll
        for (int mi = 0; mi < 4; ++mi)
#pragma unroll
            for (int ni = 0; ni < 8; ++ni) acc[mi][ni] = (f32x4){0.f, 0.f, 0.f, 0.f};
#define O_STEP(st_, a_) do { bf16x8 bq_[4]; \
            if ((st_) < nks) { _Pragma("unroll") for (int mi = 0; mi < 4; ++mi) bq_[mi] = *(const LAS bf16x8*)(pb + (16 * mi) * PSTR + 64 * (st_)); } \
            else { _Pragma("unroll") for (int mi = 0; mi < 4; ++mi) bq_[mi] = *(const bf16x8*)(qb + (size_t)(mi * 8 + ((st_) - nks)) * 512); } \
            _Pragma("unroll") for (int mi = 0; mi < 4; ++mi) _Pragma("unroll") for (int ni = 0; ni < 8; ++ni) acc[mi][ni] = MFMA16(a_[ni], bq_[mi], acc[mi][ni]); } while (0)
        for (int s2 = 0; s2 < nst; s2 += 2) {
            O_LOADA(s2 + 1, fb); O_STEP(s2, fa);
            if (s2 + 2 < nst) O_LOADA(s2 + 2, fa);
            O_STEP(s2 + 1, fb);
        }
#undef O_LOADA
#undef O_STEP
        v4u gv[4][4];
#pragma unroll
        for (int mi = 0; mi < 4; ++mi) { const bf16* gp = GF + (size_t)(b * SEQ + n * 128 + 16 * (4 * wr + mi) + 4 * wc) * 2048 + h * 512 + lane * 8;
#pragma unroll
            for (int p = 0; p < 4; ++p) gv[mi][p] = (DV & 16) ? (v4u){0u, 0u, 0u, 0u} : *(const v4u*)(gp + (size_t)p * 2048); }
#pragma unroll
        for (int mi = 0; mi < 4; ++mi) {
            float s = 0.f;
#pragma unroll
            for (int ni = 0; ni < 8; ++ni) s += (acc[mi][ni][0] + acc[mi][ni][1]) + (acc[mi][ni][2] + acc[mi][ni][3]);
            s += __shfl_xor(s, 16); s += __shfl_xor(s, 32);
            const float mw = s * (1.0f / 128.0f); float qq = 0.f;
#pragma unroll
            for (int ni = 0; ni < 8; ++ni) { const f32x4 d = acc[mi][ni] - mw; qq += (d[0] * d[0] + d[1] * d[1]) + (d[2] * d[2] + d[3] * d[3]); }
            qq += __shfl_xor(qq, 16); qq += __shfl_xor(qq, 32);
            if (g == 0) { const int i = 64 * wr + 16 * mi + c; st[(i * 4 + wc) * 2 + 0] = mw; st[(i * 4 + wc) * 2 + 1] = qq; }
        }
        asm volatile("s_waitcnt vmcnt(0)" ::: "memory");
        __syncthreads();
#pragma unroll
        for (int mi = 0; mi < 4; ++mi) {
            const int i = 64 * wr + 16 * mi + c;
            const f32x4 s01 = *(const LAS f32x4*)(st + i * 8), s23 = *(const LAS f32x4*)(st + i * 8 + 4);
            const float mean = ((s01[0] + s01[2]) + (s23[0] + s23[2])) * 0.25f;
            const float d0 = s01[0] - mean, d1 = s01[2] - mean, d2 = s23[0] - mean, d3 = s23[2] - mean;
            const float m2 = (s01[1] + s01[3]) + (s23[1] + s23[3]) + 128.0f * ((d0 * d0 + d1 * d1) + (d2 * d2 + d3 * d3));
            const float rstd = __builtin_amdgcn_rsqf(m2 * (1.0f / 512.0f) + NORM_EPS);
            bf16* op = O + (size_t)(b * SEQ + n * 128 + i) * 2048 + h * 512 + 128 * wc + 8 * g;
            if (DV & 1) op = (bf16*)(F.ws + WS_KSH) + (((size_t)(n * 128 + i) * 2048 + h * 512 + 128 * wc + 8 * g) & (4 * MiB - 1));
#pragma unroll
            for (int p = 0; p < 4; ++p) {
                const f32x4 o0 = (acc[mi][2 * p] - mean) * rstd, o1 = (acc[mi][2 * p + 1] - mean) * rstd; const v4u gq = gv[mi][p];
                v4u w; w.x = pk2h(__uint_as_float(gq.x << 16) * o0[0], __uint_as_float(gq.x & 0xffff0000u) * o0[1]); w.y = pk2h(__uint_as_float(gq.y << 16) * o0[2], __uint_as_float(gq.y & 0xffff0000u) * o0[3]);
                w.z = pk2h(__uint_as_float(gq.z << 16) * o1[0], __uint_as_float(gq.z & 0xffff0000u) * o1[1]); w.w = pk2h(__uint_as_float(gq.w << 16) * o1[2], __uint_as_float(gq.w & 0xffff0000u) * o1[3]);
                if (!(DV & 16)) *(v4u*)(op + 32 * p) = w;
            }
        }
    }
}

__device__ __forceinline__ void attn_fast2(Frame& F, int li) {
    launder_ids(F);
    bf16* Q = (bf16*)(F.ws + WS_BIG); const bf16* KS = (const bf16*)(F.ws + WS_KSH); const bf16* VTS = (const bf16*)(F.ws + WS_VSH);
    const float* sinks = F.in[I_SINKS] + li * 16;
    constexpr int KB = 32768, VSTR = 528, VB = 64 * VSTR, KOFF = 0, VOFF = 2 * KB, BOFF = VOFF + 2 * VB;
    static_assert(BOFF + 8192 <= LDSCTL_OFF, "attention LDS map");
    LAS float* bl = (LAS float*)(F.lds + BOFF);
    for (int i = F.tid; i < 16 * 128; i += 512) bl[i] = ((const float*)(F.ws + WS_BIAS))[i];
    const int tid = F.tid, lane = F.lane, c = lane & 15, g4 = lane >> 4, hg = F.wave >> 1, qh = F.wave & 1;
    v4u st[8];
#define AT_LOAD(it_) do { const int b_ = (it_) >> 8, n_ = ((it_) >> 2) & 63, hk_ = (it_) & 3; \
        _Pragma("unroll") for (int i_ = 0; i_ < 4; ++i_) { const int id_ = tid + 512 * i_; \
            { const int row_ = id_ >> 3, ch_ = id_ & 7; int kp_ = n_ * 128 - 128 + row_; kp_ = kp_ < 0 ? 0 : kp_; st[i_] = *(const v4u*)(KS + (size_t)(b_ * SEQ + kp_) * 256 + hk_ * 64 + ch_ * 8); } \
            { const int d_ = id_ >> 5, ch_ = id_ & 31; int kp_ = n_ * 128 - 128 + ch_ * 8; kp_ = kp_ < 0 ? 0 : kp_; st[4 + i_] = *(const v4u*)(VTS + (size_t)(b_ * 256 + hk_ * 64 + d_) * SEQ + kp_); } } } while (0)
#define AT_WRITE(buf_) do { _Pragma("unroll") for (int i_ = 0; i_ < 4; ++i_) { const int id_ = tid + 512 * i_; \
            { const int row_ = id_ >> 3, ch_ = id_ & 7; *(LAS v4u*)(F.lds + KOFF + (buf_) * KB + row_ * 128 + ((ch_ ^ (row_ & 7)) << 4)) = st[i_]; } \
            { const int d_ = id_ >> 5, ch_ = id_ & 31; *(LAS v4u*)(F.lds + VOFF + (buf_) * VB + d_ * VSTR + ch_ * 16) = st[4 + i_]; } } } while (0)
    int it = F.vcu, buf = 0;
    if (it < 512) { AT_LOAD(it); AT_WRITE(0); }
    __syncthreads();
    for (; it < 512; it += F.G, buf ^= 1) {
        const int itn = it + F.G;
        if (itn < 512) AT_LOAD(itn);
        const int b = it >> 8, n = (it >> 2) & 63, hk = it & 3, head = hk * 4 + hg;
        const float sink = sinks[head];
        const LAS float* bh_ = bl + head * 128;
        const LAS unsigned char* Kl = F.lds + KOFF + buf * KB; const LAS unsigned char* Vl = F.lds + VOFF + buf * VB;
        for (int mt = 0; mt < 4; ++mt) {
            const int i0 = 64 * qh + 16 * mt;
            const int kp0 = n * 128 - 128 + i0;
            bf16* qrow = Q + (size_t)(b * SEQ + n * 128 + i0 + c) * 1024 + head * 64;
            const bf16x8 q0 = *(const bf16x8*)(qrow + 8 * g4), q1 = *(const bf16x8*)(qrow + 32 + 8 * g4);
            f32x4 s[10];
#pragma unroll
            for (int kt = 0; kt < 9; ++kt) {
                const int r = i0 + 16 * kt + c;
                const bf16x8 k0 = *(const LAS bf16x8*)(Kl + r * 128 + ((g4 ^ (r & 7)) << 4)), k1 = *(const LAS bf16x8*)(Kl + r * 128 + (((4 + g4) ^ (r & 7)) << 4));
                f32x4 z = {0.f, 0.f, 0.f, 0.f};
                z = MFMA16(k0, q0, z); s[kt] = MFMA16(k1, q1, z);
            }
            float mx = sink;
#pragma unroll
            for (int kt = 0; kt < 9; ++kt)
#pragma unroll
                for (int e = 0; e < 4; ++e) {
                    const int jr = 16 * kt + 4 * g4 + e, dist = 128 + c - jr;
                    const bool ok = (dist >= 0) && (dist < 128) && (kp0 + jr >= 0);
                    const float v = ok ? s[kt][e] * 0.125f + bh_[dist & 127] : -INFINITY;
                    s[kt][e] = v; mx = fmaxf(mx, v);
                }
            mx = fmaxf(mx, __shfl_xor(mx, 16)); mx = fmaxf(mx, __shfl_xor(mx, 32));
            float sum = 0.f;
#pragma unroll
            for (int kt = 0; kt < 9; ++kt)
#pragma unroll
                for (int e = 0; e < 4; ++e) { const float p = __expf(s[kt][e] - mx); s[kt][e] = p; sum += p; }
            sum += __shfl_xor(sum, 16); sum += __shfl_xor(sum, 32);
            const float rden = 1.0f / (sum + __expf(sink - mx));
            s[9] = (f32x4){0.f, 0.f, 0.f, 0.f};
            f32x4 o[4];
#pragma unroll
            for (int dt = 0; dt < 4; ++dt) o[dt] = (f32x4){0.f, 0.f, 0.f, 0.f};
#pragma unroll
            for (int kk = 0; kk < 5; ++kk) {
                v4u pw; pw.x = pk2h(s[2 * kk][0] * rden, s[2 * kk][1] * rden); pw.y = pk2h(s[2 * kk][2] * rden, s[2 * kk][3] * rden);
                pw.z = pk2h(s[2 * kk + 1][0] * rden, s[2 * kk + 1][1] * rden); pw.w = pk2h(s[2 * kk + 1][2] * rden, s[2 * kk + 1][3] * rden);
                const bf16x8 pb = __builtin_bit_cast(bf16x8, pw);
                int ka = i0 + 32 * kk + 4 * g4, kb = ka + 16; ka = ka > 252 ? 252 : ka; kb = kb > 252 ? 252 : kb;
#pragma unroll
                for (int dt = 0; dt < 4; ++dt) {
                    const v2u va = *(const LAS v2u*)(Vl + (16 * dt + c) * VSTR + ka * 2), vb = *(const LAS v2u*)(Vl + (16 * dt + c) * VSTR + kb * 2);
                    const v4u vw = {va.x, va.y, vb.x, vb.y};
                    o[dt] = MFMA16(__builtin_bit_cast(bf16x8, vw), pb, o[dt]);
                }
            }
            bf16* orow = F.dry ? qrow + (size_t)16 * MiB : qrow;
#pragma unroll
            for (int dt = 0; dt < 4; ++dt) { v2u w; w.x = pk2h(o[dt][0], o[dt][1]); w.y = pk2h(o[dt][2], o[dt][3]); *(v2u*)(orow + 16 * dt + 4 * g4) = w; }
        }
        if (itn < 512) AT_WRITE(buf ^ 1);
        __syncthreads();
    }
#undef AT_LOAD
#undef AT_WRITE
}


constexpr int N_PHASES = 2 + 2 * 9 + 2 * 8;
struct Args { const float* in[19]; float* out; unsigned char* ws; int ph_lo, ph_hi, dry, pad; };
static_assert(sizeof(Args) == 19 * 8 + 8 + 8 + 16, "Args has no padding");

__global__ void __launch_bounds__(NWAVES * 64, 2) yoco_fwd(Args args) {
    extern __shared__ __attribute__((aligned(16))) unsigned char lds[];
    Frame F;
    F.lds = (LAS unsigned char*)lds;
    F.MISC = (volatile LAS unsigned*)(F.lds + MISC_OFF);
    F.G = gridDim.x; { const int bx = blockIdx.x; F.vcu = (F.G % 8 == 0) ? (bx % 8) * (F.G / 8) + bx / 8 : bx; }
    for (int u = threadIdx.x; u < (LDS_BYTES - LDSCTL_OFF) / 4; u += NWAVES * 64) ((LAS unsigned*)(F.lds + LDSCTL_OFF))[u] = 0u;
    __syncthreads();
    XcdBarrier bar; bar.bar = (unsigned*)(args.ws + WS_CTL) + CW_BAR; bar.x = 0; bar.st = nullptr;
    if (MK_N_LAUNCHES == 1) bar = xcd_barrier_post((unsigned*)(args.ws + WS_CTL) + CW_BAR, F.MISC + 8);

    int ph_first = args.ph_lo;
    if (ph_first == 0) {
        const Args __attribute__((address_space(4)))* ap = (const Args __attribute__((address_space(4)))*)__builtin_amdgcn_kernarg_segment_ptr();
        asm volatile("" : "+s"(ap));
        F.in = (const float* __attribute__((address_space(4)))*)&ap->in[0]; F.out = ap->out; F.ws = ap->ws; F.ctl = (gu32*)(F.ws + WS_CTL);
        phase_mods(F); phase_tables(F); phase_weights(F, 0);
        if (args.ph_hi > 1) { if (MK_N_LAUNCHES == 1) xcd_barrier(bar); }
        ph_first = 1;
    }
    for (int ph = ph_first; ph < args.ph_hi; ++ph) {
        const Args __attribute__((address_space(4)))* ap = (const Args __attribute__((address_space(4)))*)__builtin_amdgcn_kernarg_segment_ptr();
        asm volatile("" : "+s"(ap));
        F.in = (const float* __attribute__((address_space(4)))*)&ap->in[0]; F.out = ap->out; F.ws = ap->ws; F.ctl = (gu32*)(F.ws + WS_CTL); F.dry = ap->dry;
        unsigned char* ws = F.ws;
        bf16* const H = (bf16*)(ws + WS_R); bf16* const HKV = (bf16*)(ws + WS_R + 32 * MiB); bf16* const ACT = (bf16*)(ws + WS_R);
        bf16* const BIG = (bf16*)(ws + WS_BIG);
        const float* const MODS = (const float*)(ws + WS_MODS); const float* const KVMOD = (const float*)(ws + WS_KVMOD);
        int layer = -1, sub = -1;
        if (ph >= 2) { int p = ph - 2; if (p < 18) { layer = p / 9; sub = p % 9; } else { p -= 18; layer = 2 + p / 8; sub = 10 + p % 8; } }
        const bool ret = layer >= 0 && layer < 2;
        const bool is_rp_start = (ph == 1);
        const bool is_rp_mid = (sub == 4) || (sub == 13);
        const bool is_rp_end = (sub == 8) || (sub == 17);
        const bool is_conv = (sub == 6) || (sub == 15);
        const bool is_gemm_out = (sub == 3) || (sub == 12);
        const bool is_gemm_up = (sub == 5) || (sub == 14);
        const bool is_gemm_down = (sub == 7) || (sub == 16);
        const bool is_gemm_q = (sub == 10);

        if (is_rp_start || is_rp_mid || is_rp_end) {
            RowPass P{};
            if (is_rp_start) {
                P.xsrc = F.in[I_X]; P.xdst = nullptr; P.y = nullptr;
                P.h1 = H; P.g1 = F.in[I_NORMG] + (0 * 4 + 0) * D; P.sc1 = MODS + 1 * D; P.sh1 = MODS + 0 * D; P.st1 = 6144;
            } else if (is_rp_mid) {
                P.xsrc = (layer == 0) ? F.in[I_X] : F.out; P.xdst = F.out;
                P.y = ret ? BIG : BIG + (size_t)16 * MiB;
                P.gpost = F.in[I_NORMG] + (layer * 4 + 1) * D; P.gate = MODS + (size_t)layer * 2 * 6144 + 2 * D; P.gstride = 6144;
                P.h1 = H; P.g1 = F.in[I_NORMG] + (layer * 4 + 2) * D; P.sc1 = MODS + (size_t)layer * 2 * 6144 + 4 * D; P.sh1 = MODS + (size_t)layer * 2 * 6144 + 3 * D; P.st1 = 6144;
            } else {
                P.xsrc = F.out; P.xdst = F.out; P.y = BIG;
                P.gpost = F.in[I_NORMG] + (layer * 4 + 3) * D; P.gate = MODS + (size_t)layer * 2 * 6144 + 5 * D; P.gstride = 6144;
                if (layer < 3) { P.h1 = H; P.g1 = F.in[I_NORMG] + ((layer + 1) * 4 + 0) * D; P.sc1 = MODS + (size_t)(layer + 1) * 2 * 6144 + 1 * D; P.sh1 = MODS + (size_t)(layer + 1) * 2 * 6144; P.st1 = 6144; }
                if (layer == 1) { P.h2 = HKV; P.g2 = F.in[I_KVNG]; P.sc2 = KVMOD + D; P.sh2 = KVMOD; P.st2 = 2048; }
            }
            if (F.dry) P.xdst = nullptr;
            phase_rowpass(F, P);
            if (is_rp_end && layer < 3) phase_weights(F, layer + 1);
        }

        if (sub == 0) {
            pg8::Gemm g{H, (const bf16*)(ws + WS_WT_IN), M, 4096, D}; pg8::StaticOrder S; S.init(M, 4096, F.G, (int)blockIdx.x);
            pg8::EpiRetQKG E{BIG, BIG + (size_t)16 * MiB, BIG + (size_t)64 * MiB, (const float*)(ws + WS_COS), (const float*)(ws + WS_SIN), (const float*)(ws + WS_SCQ), (const float*)(ws + WS_SCK)};
            pg8::gemm_phase<pg8::EpiRetQKG, pg8::StaticOrder, true, true>(F.lds + RING_OFF, g, S, E);
        }
        if (sub == 0 || (sub == 10 && layer == 2)) {
            pg8::Gemm g{}; pg8::EpiVT E{}; int cid = (int)blockIdx.x;
            if (sub == 0) { g = pg8::Gemm{(const bf16*)(ws + WS_WT_IN) + (size_t)4096 * D, H, 2048, M, D}; E.VT = BIG + (size_t)32 * MiB; E.mode = 0; }
            else { g = pg8::Gemm{(const bf16*)(ws + WS_WT_KV) + (size_t)256 * D, HKV, 256, M, D}; E.VT = (bf16*)(ws + WS_VSH); E.mode = 1; cid = (cid + F.G / 2) % F.G; }
            pg8::StaticOrder S; S.init(g.M, g.N, F.G, cid);
            pg8::gemm_phase<pg8::EpiVT, pg8::StaticOrder, true, true>(F.lds + RING_OFF, g, S, E);
        }
        if (sub == 1) { pass1_f(F); }
#if PROBE_MASK != 0
        if (sub == 2) { if (F.dry) pass2_f<DRY_VARIANT>(F); else pass2_f<0>(F); }
#else
        if (sub == 2) { pass2_f<0>(F); }
#endif
        if (sub == 11) { attn_fast2(F, layer - 2); }
        if (is_conv) { phase_conv(F, layer); }

        if (is_gemm_out || is_gemm_up || is_gemm_down || is_gemm_q) {
            const int ng = (is_gemm_q && layer == 2) ? 2 : 1;
            for (int gi = 0; gi < ng; ++gi) {
                pg8::Gemm g{}; pg8::EpiBf16S E{};
                E.scale = 1.0f; E.split_cols = 0; E.split_stride = 0;
                if (is_gemm_q) {
                    if (gi == 0) { g = pg8::Gemm{H, (const bf16*)(ws + WS_WT_IN), M, D, D}; E.O = BIG; E.ldc = D; }
                    else { g = pg8::Gemm{HKV, (const bf16*)(ws + WS_WT_KV), M, 256, D}; E.O = (bf16*)(ws + WS_KSH); E.ldc = 256; }
                } else if (is_gemm_out) {
                    if (ret) { g = pg8::Gemm{BIG + (size_t)64 * MiB, (const bf16*)(ws + WS_WT_OUT), M, D, 2048}; E.O = BIG; E.ldc = D; }
                    else { g = pg8::Gemm{BIG, (const bf16*)(ws + WS_WT_OUT), M, D, D}; E.O = BIG + (size_t)16 * MiB; E.ldc = D; }
                } else if (is_gemm_up) {
                    g = pg8::Gemm{H, (const bf16*)(ws + WS_WT_UP), M, FF2, D}; E.O = BIG; E.ldc = FF2;
                } else {
                    g = pg8::Gemm{ACT, (const bf16*)(ws + WS_WT_DOWN), M, D, FF}; E.O = BIG; E.ldc = D;
                }
                pg8::StaticOrder S; S.init(g.M, g.N, F.G, (int)blockIdx.x);
                pg8::gemm_phase<pg8::EpiBf16S, pg8::StaticOrder, true, true>(F.lds + RING_OFF, g, S, E);
            }
        }

        if (ph + 1 < args.ph_hi) { if (MK_N_LAUNCHES == 1) xcd_barrier(bar); }
    }
}

extern "C" void kernel_launch(void* const* d_in, const int* in_sizes, int n_in, void* d_out, int out_size, void* d_ws, size_t ws_size, hipStream_t stream) {
    static int grid = 0;
    if (grid == 0) {
        if (n_in != 19 || in_sizes[0] != M * D || out_size != M * D || ws_size < WS_END) { fprintf(stderr, "kernel_launch: unexpected problem (n_in %d, in0 %d, out %d, ws %zu); nothing launched\n", n_in, n_in > 0 ? in_sizes[0] : -1, out_size, ws_size); grid = -1; return; }
        int dev = 0, cus = 0;
        if (hipGetDevice(&dev) != hipSuccess || hipDeviceGetAttribute(&cus, hipDeviceAttributeMultiprocessorCount, dev) != hipSuccess) { grid = -1; return; }
        if (hipFuncSetAttribute((const void*)yoco_fwd, hipFuncAttributeMaxDynamicSharedMemorySize, LDS_BYTES) != hipSuccess) { fprintf(stderr, "kernel_launch: hipFuncSetAttribute failed\n"); grid = -1; return; }
        int per_cu = 0;
        if (hipOccupancyMaxActiveBlocksPerMultiprocessor(&per_cu, (const void*)yoco_fwd, NWAVES * 64, LDS_BYTES) != hipSuccess || per_cu < 1) fprintf(stderr, "kernel_launch: note: occupancy query reports %d workgroups per CU\n", per_cu);
        (void)hipGetLastError();
        if (cus != 256) { fprintf(stderr, "kernel_launch: this kernel is laid out for 256 CUs, found %d; nothing launched\n", cus); grid = -1; return; }
        grid = cus;
    }
    if (grid < 0) return;
    if (hipMemsetAsync((char*)d_ws + WS_CTL, 0, CTL_ZERO_BYTES, stream) != hipSuccess) return;
    Args a{};
    for (int i = 0; i < 19; ++i) a.in[i] = (const float*)d_in[i];
    a.out = (float*)d_out; a.ws = (unsigned char*)d_ws;
    if (MK_N_LAUNCHES == 1) {
        a.ph_lo = 0; a.ph_hi = N_PHASES;
        hipLaunchKernelGGL(yoco_fwd, dim3(grid), dim3(NWAVES * 64), LDS_BYTES, stream, a);
    } else {
        for (int ph = 0; ph < N_PHASES; ++ph) {
            int sub = -1; if (ph >= 2) { int p = ph - 2; if (p < 18) sub = p % 9; else sub = 10 + (p - 18) % 8; }
            int kind = 0;
            if (ph == 0) kind = 8; else if (ph == 1) kind = 16; else if (sub == 0) kind = 256; else if (sub == 3) kind = 512; else if (sub == 5 || sub == 14) kind = 1024; else if (sub == 7 || sub == 16) kind = 2048;
            else if (sub == 10 || sub == 12) kind = 4096; else if (sub == 6 || sub == 15) kind = 2; else if (sub == 1) kind = 4;
            else if (sub == 2) kind = 32; else if (sub == 11) kind = 64; else if (sub == 4 || sub == 13) kind = 128; else if (sub == 8 || sub == 17) kind = 8192;
            const int nrep = (PROBE_MASK & kind) ? 2 : 1; const bool inplace = (kind == 32 || kind == 64 || kind == 128 || kind == 8192);
            for (int rep = 0; rep < nrep; ++rep) { a.ph_lo = ph; a.ph_hi = ph + 1; a.dry = (inplace && nrep == 2 && rep == 0) ? DRY_VARIANT : 0; hipLaunchKernelGGL(yoco_fwd, dim3(grid), dim3(NWAVES * 64), LDS_BYTES, stream, a); }
        }
    }
}
```

```cpp
#include <hip/hip_runtime.h>
#include <cstdio>
#include <cstdint>

#ifndef MK_N_LAUNCHES
#define MK_N_LAUNCHES 1
#endif
#ifndef PROBE_MASK
#define PROBE_MASK 0
#endif
#ifndef DRY_VARIANT
#define DRY_VARIANT 1
#endif
#ifndef NAIVE_P1
#define NAIVE_P1 0
#endif
#ifndef NAIVE_P2
#define NAIVE_P2 0
#endif
#ifndef NAIVE_ATT
#define NAIVE_ATT 0
#endif

constexpr int BATCH = 2, SEQ = 8192, D = 1024, M = BATCH * SEQ, DEPTH = 4;
constexpr int RH = 4, RDK = 256, RDV = 512, RC = 128, NCH = SEQ / RC;
constexpr int RETN = 6144, FF = 2816, FF2 = 5632;
constexpr int SHEADS = 16, SKVH = 4, SHD = 64, WIN = 128;
constexpr float NORM_EPS = 1e-6f;

namespace pg8 {
#define PG8_LAS __attribute__((address_space(3)))
typedef unsigned short bf16_t;
typedef short bf16x8 __attribute__((ext_vector_type(8)));
typedef float f32x4 __attribute__((ext_vector_type(4)));
typedef unsigned u32x4 __attribute__((ext_vector_type(4)));
constexpr int BM = 256, BK = 64, HALF = 128, HTB = HALF * BK * 2  , STAGE_BYTES = 8 * HTB, NXCD = 8, WGM = 8;

__host__ __device__ __forceinline__ int lds_byte(int r, int c) { const int st = (r >> 4) * 2 + (c >> 5), rr = r & 15, cc = c & 31, ob = rr * 64 + cc * 2; return st * 1024 + (ob ^ (((ob >> 9) & 1) << 5)); }
__host__ __device__ __forceinline__ void stage_rc(int b, int& R, int& C) { const int st = b / 1024, sb = b % 1024, swz = sb ^ (((sb >> 9) & 1) << 5); R = (st >> 1) * 16 + swz / 64; C = (st & 1) * 32 + (swz % 64) / 2; }
__host__ __device__ __forceinline__ int perm32(int rho) { const int n = rho >> 4, i = rho & 15; return 8 * (i >> 2) + 4 * n + (i & 3); }

struct Unit { int pm, pn; };
struct Gemm { const bf16_t* A; const bf16_t* Bt; int M, N, K; };

struct StaticOrder {
    int nM, nN, nwg, G, c;
    __host__ __device__ void init(int M, int N, int G_, int c_) { nM = M / BM; nN = N / BM; nwg = nM * nN; G = G_; c = c_; }
    __host__ __device__ bool next(int i, Unit& u) const {
        const long L = (long)i * G + c; if (L >= nwg) return false;
        int wgid = (int)L; { const int q = nwg / NXCD, r = nwg % NXCD, xcd = wgid % NXCD, off = wgid / NXCD; wgid = (xcd < r ? xcd * (q + 1) : r * (q + 1) + (xcd - r) * q) + off; }
        const int nig = WGM * nN, gid = wgid / nig, fm = gid * WGM, gsz = (nM - fm) < WGM ? (nM - fm) : WGM;
        u.pm = fm + ((wgid % nig) % gsz); u.pn = (wgid % nig) / gsz; return true;
    }
    __device__ __forceinline__ void a_ready(const Unit&) const {}
    __device__ __forceinline__ void done(const Unit&) const {}
};
__device__ __forceinline__ unsigned cvt_pk_bf16(float lo, float hi) { unsigned r; asm volatile("v_cvt_pk_bf16_f32 %0, %1, %2" : "=v"(r) : "v"(lo), "v"(hi)); return r; }
typedef float f32x2 __attribute__((ext_vector_type(2)));
__device__ __forceinline__ float silu_f(float x) { return x * __builtin_amdgcn_rcpf(1.0f + __expf(-x)); }
__device__ __forceinline__ u32x4 pack8(const f32x4 v0, const f32x4 v1) { u32x4 w; w.x = cvt_pk_bf16(v0[0], v0[1]); w.y = cvt_pk_bf16(v0[2], v0[3]); w.z = cvt_pk_bf16(v1[0], v1[1]); w.w = cvt_pk_bf16(v1[2], v1[3]); return w; }

struct EpiBf16S {
    static constexpr bool PERM = true, AFTER_DRAIN = false;
    bf16_t* O; int ldc; int split_cols; size_t split_stride; float scale;
    __device__ __forceinline__ void operator()(const f32x4 (&acc)[2][2][4][2], const Unit& u, int wr, int wc, int fr, int fq) const {
        const int row0 = u.pm * BM + wr * 64 + fr; int colt = u.pn * BM; bf16_t* base = O;
        if (split_cols) { const int t = colt / split_cols; base += (size_t)t * split_stride; colt -= t * split_cols; }
        const int col0 = colt + wc * 32 + 8 * fq;
#pragma unroll
        for (int ai = 0; ai < 2; ++ai)
#pragma unroll
            for (int m = 0; m < 4; ++m) { bf16_t* rowp = base + (size_t)(row0 + ai * HALF + m * 16) * ldc + col0;
#pragma unroll
                for (int bj = 0; bj < 2; ++bj) *(u32x4*)(rowp + bj * HALF) = pack8(acc[ai][bj][m][0] * scale, acc[ai][bj][m][1] * scale); }
    }
};

struct EpiRetQKG {
    static constexpr bool PERM = true, AFTER_DRAIN = false;
    bf16_t* QT; bf16_t* KT; bf16_t* G; const float* cosT; const float* sinT; const float* scq; const float* sck;
    __device__ __forceinline__ void operator()(const f32x4 (&acc)[2][2][4][2], const Unit& u, int wr, int wc, int fr, int fq) const {
        const int row0 = u.pm * BM + wr * 64 + fr;
        if (u.pn < 8) {
            const int head = u.pn & 3; const bool isk = u.pn >= 4;
            const float* sct = (isk ? sck : scq) + head * 128;
            const int ci = wc * 32 + 8 * fq;
#pragma unroll
            for (int ai = 0; ai < 2; ++ai)
#pragma unroll
                for (int m = 0; m < 4; ++m) {
                    const int row = row0 + ai * HALF + m * 16, pos = row & (SEQ - 1);
                    const float s = sct[pos & 127];
                    const f32x4 c0 = *(const f32x4*)(cosT + (size_t)pos * 128 + ci), c1 = *(const f32x4*)(cosT + (size_t)pos * 128 + ci + 4);
                    const f32x4 s0 = *(const f32x4*)(sinT + (size_t)pos * 128 + ci), s1 = *(const f32x4*)(sinT + (size_t)pos * 128 + ci + 4);
                    const f32x4 a0 = acc[ai][0][m][0], a1 = acc[ai][0][m][1], b0 = acc[ai][1][m][0], b1 = acc[ai][1][m][1];
                    const f32x4 o10 = (a0 * c0 - b0 * s0) * s, o11 = (a1 * c1 - b1 * s1) * s, o20 = (b0 * c0 + a0 * s0) * s, o21 = (b1 * c1 + a1 * s1) * s;
                    const int bb = row >> 13, nn = (row & (SEQ - 1)) >> 7, it = ((row & 127) >> 4);
                    bf16_t* tp = (isk ? KT : QT) + ((size_t)((bb * 64 + nn) * 4 + head) * 32768) + (size_t)((it * 8 + wc) * 512) + (fq * 16 + fr) * 8;
                    *(u32x4*)(tp) = pack8(o10, o11); *(u32x4*)(tp + 4 * 512) = pack8(o20, o21);
                }
        } else {
            const int gh = (u.pn - 8) >> 1, pb = ((u.pn - 8) & 1) * 8 + wc;
#pragma unroll
            for (int ai = 0; ai < 2; ++ai)
#pragma unroll
                for (int m = 0; m < 4; ++m) { const int row = row0 + ai * HALF + m * 16, bb = row >> 13, nn = (row & (SEQ - 1)) >> 7, it = ((row & 127) >> 4);
                    bf16_t* tp = G + (size_t)(bb * SEQ + nn * 128 + it * 16 + pb) * 2048 + gh * 512 + (fq * 16 + fr) * 8;
#pragma unroll
                    for (int bj = 0; bj < 2; ++bj) { f32x4 v0 = acc[ai][bj][m][0], v1 = acc[ai][bj][m][1];
#pragma unroll
                        for (int e = 0; e < 4; ++e) { v0[e] = silu_f(v0[e]); v1[e] = silu_f(v1[e]); }
                        *(u32x4*)(tp + (size_t)bj * 4 * 2048) = pack8(v0, v1); } }
        }
    }
};

struct EpiVT {
    static constexpr bool PERM = true, AFTER_DRAIN = false;
    bf16_t* VT; int mode;
    __device__ __forceinline__ void operator()(const f32x4 (&acc)[2][2][4][2], const Unit& u, int wr, int wc, int fr, int fq) const {
        const int ch0 = u.pm * BM + wr * 64 + fr, tok0 = u.pn * BM + wc * 32 + 8 * fq;
#pragma unroll
        for (int ai = 0; ai < 2; ++ai)
#pragma unroll
            for (int m = 0; m < 4; ++m) { const int ch = ch0 + ai * HALF + m * 16, h = ch >> 9, dv = ch & 511;
#pragma unroll
                for (int bj = 0; bj < 2; ++bj) { const int tok = tok0 + bj * HALF, b = tok >> 13, sp = tok & (SEQ - 1), chunk = sp >> 7, j = sp & 127;
                    bf16_t* p = mode == 0 ? VT + ((size_t)((b * 4 + h) * 64 + chunk) * 65536) + (size_t)(((dv >> 4) * 4 + wc) * 512) + (fq * 16 + fr) * 8 : VT + ((size_t)(b * 256 + ch) * SEQ + sp);
                    *(u32x4*)p = pack8(acc[ai][bj][m][0], acc[ai][bj][m][1]); } }
    }
};


template <int N> __device__ __forceinline__ float dpp_ror(float v) { return __builtin_bit_cast(float, __builtin_amdgcn_update_dpp(0, __builtin_bit_cast(int, v), 0x120 + N, 0xf, 0xf, false)); }
template <int N> __device__ __forceinline__ float dpp_shr_old(float old, float v) { return __builtin_bit_cast(float, __builtin_amdgcn_update_dpp(__builtin_bit_cast(int, old), __builtin_bit_cast(int, v), 0x110 + N, 0xf, 0xf, false)); }
struct EpiUpConv {
    static constexpr bool PERM = true, AFTER_DRAIN = false;
    bf16_t* A; bf16_t* HALO; const float* cw; const float* cb;
    __device__ __forceinline__ void operator()(const f32x4 (&acc)[2][2][4][2], const Unit& u, int wr, int wc, int fr, int fq) const {
        const int ch0 = u.pn * 128 + wc * 32 + 8 * fq;
#pragma unroll
        for (int ai = 0; ai < 2; ++ai) {
            const int rowb = u.pm * BM + ai * HALF + wr * 64, blk = rowb >> 6;
            { bf16_t* hp = HALO + ((size_t)blk * 4) * 5632 + u.pn * 256 + wc * 32 + 8 * fq;
              if (fr < 2) { *(u32x4*)(hp + (size_t)fr * 5632) = pack8(acc[ai][0][0][0], acc[ai][0][0][1]); *(u32x4*)(hp + (size_t)fr * 5632 + 128) = pack8(acc[ai][1][0][0], acc[ai][1][0][1]); }
              if (fr >= 14) { *(u32x4*)(hp + (size_t)(fr - 12) * 5632) = pack8(acc[ai][0][3][0], acc[ai][0][3][1]); *(u32x4*)(hp + (size_t)(fr - 12) * 5632 + 128) = pack8(acc[ai][1][3][0], acc[ai][1][3][1]); } }
            unsigned pk[4][4];
#pragma unroll
            for (int n = 0; n < 2; ++n) {
                f32x4 wg0 = *(const f32x4*)(cw + ch0 + 4 * n), wg1 = *(const f32x4*)(cw + 5632 + ch0 + 4 * n), wg2 = *(const f32x4*)(cw + 2 * 5632 + ch0 + 4 * n), bg = *(const f32x4*)(cb + ch0 + 4 * n);
                f32x4 wv0 = *(const f32x4*)(cw + 2816 + ch0 + 4 * n), wv1 = *(const f32x4*)(cw + 5632 + 2816 + ch0 + 4 * n), wv2 = *(const f32x4*)(cw + 2 * 5632 + 2816 + ch0 + 4 * n), bv = *(const f32x4*)(cb + 2816 + ch0 + 4 * n);
                float keep[4];
#pragma unroll
                for (int e = 0; e < 4; ++e) {
                    float ug[4], uv[4];
                    { float r1p = 0.f, r2p = 0.f;
#pragma unroll
                      for (int m = 0; m < 4; ++m) { const float x = acc[ai][0][m][n][e];
                          const float p1 = dpp_shr_old<1>(r1p, x), p2 = dpp_shr_old<2>(r2p, x);
                          r1p = dpp_ror<1>(x); r2p = dpp_ror<2>(x);
                          ug[m] = bg[e] + wg0[e] * p2 + wg1[e] * p1 + wg2[e] * x; } }
                    { float r1p = 0.f, r2p = 0.f;
#pragma unroll
                      for (int m = 0; m < 4; ++m) { const float x = acc[ai][1][m][n][e];
                          const float p1 = dpp_shr_old<1>(r1p, x), p2 = dpp_shr_old<2>(r2p, x);
                          r1p = dpp_ror<1>(x); r2p = dpp_ror<2>(x);
                          uv[m] = bv[e] + wv0[e] * p2 + wv1[e] * p1 + wv2[e] * x; } }
#pragma unroll
                    for (int m = 0; m < 4; ++m) { const float r = silu_f(ug[m]) * uv[m]; if ((e & 1) == 0) keep[m] = r; else pk[m][n * 2 + (e >> 1)] = cvt_pk_bf16(keep[m], r); }
                }
            }
#pragma unroll
            for (int m = 0; m < 4; ++m) {
                if (m > 0 || fr >= 2) { u32x4 w; w.x = pk[m][0]; w.y = pk[m][1]; w.z = pk[m][2]; w.w = pk[m][3]; *(u32x4*)(A + (size_t)(rowb + m * 16 + fr) * 2816 + ch0) = w; }
            }
        }
    }
};
template <class Epi, class Sched, bool ALIGN_EPI = false, bool SP2 = false>
__device__ __forceinline__ void gemm_phase(PG8_LAS unsigned char* lds, const Gemm g, const Sched& S, const Epi& E) {
    int tid_l = threadIdx.x; asm volatile("" : "+v"(tid_l));
    const int tid = tid_l, wid = __builtin_amdgcn_readfirstlane(tid >> 6), lane = tid & 63, wr = wid >> 2, wc = wid & 3, fr = lane & 15, fq = lane >> 4;
    const int K = g.K, nt = K / BK;
    unsigned voffA[2], voffB[2];
#pragma unroll
    for (int i = 0; i < 2; ++i) { int R, C; stage_rc(tid * 16 + i * 8192, R, C); const int Rb = Epi::PERM ? ((R & ~31) + perm32(R & 31)) : R;
        voffA[i] = (unsigned)(R * K + C) * 2u; voffB[i] = (unsigned)(Rb * K + C) * 2u; }
    const size_t kstep = (size_t)(BK * 2);
    const size_t hstep = (size_t)HALF * K * 2;
    const size_t tstep = 2 * hstep;
    const unsigned ldsw = (unsigned)wid * 1024u;
    const int aoff = lds_byte(wr * 64 + fr, fq * 8), boff = lds_byte(wc * 32 + fr, fq * 8);
#define PG8_SA(b, h) (((b) * 2 + (h)) * HTB)
#define PG8_SB(b, h) ((4 + (b) * 2 + (h)) * HTB)
#define PG8_STAGE(bufoff, gbase, voff) do { _Pragma("unroll") for (int _i = 0; _i < 2; ++_i) \
        __builtin_amdgcn_global_load_lds((const unsigned*)((const char*)(gbase) + (voff)[_i]), (PG8_LAS unsigned*)(lds + (bufoff) + ldsw + _i * 8192), 16, 0, 0); } while (0)
#define PG8_LDA(dst, b, h) do { _Pragma("unroll") for (int m = 0; m < 4; ++m) _Pragma("unroll") for (int k = 0; k < 2; ++k) dst[m][k] = *(const PG8_LAS bf16x8*)(lds + PG8_SA(b, h) + aoff + m * 2048 + k * 1024); } while (0)
#define PG8_LDB(dst, b, h) do { _Pragma("unroll") for (int n = 0; n < 2; ++n) _Pragma("unroll") for (int k = 0; k < 2; ++k) dst[n][k] = *(const PG8_LAS bf16x8*)(lds + PG8_SB(b, h) + boff + n * 2048 + k * 1024); } while (0)
#define PG8_MMA(ai, bj, At, Bt) do { __builtin_amdgcn_s_setprio(1); _Pragma("unroll") for (int m = 0; m < 4; ++m) _Pragma("unroll") for (int n = 0; n < 2; ++n) _Pragma("unroll") for (int k = 0; k < 2; ++k) \
        acc[ai][bj][m][n] = __builtin_amdgcn_mfma_f32_16x16x32_bf16(Bt[n][k], At[m][k], acc[ai][bj][m][n], 0, 0, 0); __builtin_amdgcn_s_setprio(0); } while (0)
#define PG8_WAIT_V(n) asm volatile("s_waitcnt vmcnt(" #n ")" ::: "memory")
#define PG8_WAIT_L(n) asm volatile("s_waitcnt lgkmcnt(" #n ")" ::: "memory")
#define PG8_BAR __builtin_amdgcn_s_barrier()
#define PG8_SCHED __builtin_amdgcn_sched_barrier(0)
    Unit cur, nxt; int ui = 0;
    if (!S.next(0, cur)) return;
    f32x4 acc[2][2][4][2];
#pragma unroll
    for (int a = 0; a < 2; ++a)
#pragma unroll
        for (int b = 0; b < 2; ++b)
#pragma unroll
            for (int m = 0; m < 4; ++m)
#pragma unroll
                for (int n = 0; n < 2; ++n) acc[a][b][m][n] = (f32x4){0.f, 0.f, 0.f, 0.f};
    bf16x8 At[4][2], B0[2][2], B1[2][2];
    const char* cA = (const char*)g.A + (size_t)cur.pm * tstep; const char* cB = (const char*)g.Bt + (size_t)cur.pn * tstep;
    S.a_ready(cur);
    if constexpr (SP2) {
        PG8_STAGE(PG8_SB(0, 0), cB, voffB); PG8_STAGE(PG8_SB(0, 1), cB + hstep, voffB); PG8_STAGE(PG8_SA(0, 0), cA, voffA); PG8_STAGE(PG8_SA(0, 1), cA + hstep, voffA);
        if (wr == 1) PG8_BAR;
        PG8_WAIT_V(2); PG8_BAR;
        PG8_STAGE(PG8_SB(1, 0), cB + kstep, voffB); PG8_STAGE(PG8_SA(1, 0), cA + kstep, voffA); PG8_STAGE(PG8_SB(1, 1), cB + hstep + kstep, voffB);
        PG8_WAIT_V(6); PG8_BAR;
    } else {
        PG8_STAGE(PG8_SB(0, 0), cB, voffB); PG8_STAGE(PG8_SA(0, 0), cA, voffA); PG8_STAGE(PG8_SB(0, 1), cB + hstep, voffB); PG8_STAGE(PG8_SA(0, 1), cA + hstep, voffA);
        if (wr == 1) PG8_BAR;
        PG8_WAIT_V(4); PG8_BAR;
        PG8_STAGE(PG8_SB(1, 0), cB + kstep, voffB); PG8_STAGE(PG8_SA(1, 0), cA + kstep, voffA); PG8_STAGE(PG8_SB(1, 1), cB + hstep + kstep, voffB);
        PG8_WAIT_V(6); PG8_BAR;
    }
    for (;;) {
        const bool has_next = S.next(ui + 1, nxt);
        const char* nA = has_next ? (const char*)g.A + (size_t)nxt.pm * tstep : cA; const char* nB = has_next ? (const char*)g.Bt + (size_t)nxt.pn * tstep : cB;
        for (int t = 0; t < nt; t += 2) {
            const bool last = (t == nt - 2);
            const char* a1 = cA + (size_t)(t + 1) * kstep;
            const char* a2 = last ? nA : cA + (size_t)(t + 2) * kstep; const char* b2 = last ? nB : cB + (size_t)(t + 2) * kstep;
            const char* a3 = a2 + kstep; const char* b3 = b2 + kstep;
            if (last && has_next) S.a_ready(nxt);
            if constexpr (SP2) {
            PG8_LDB(B0, 0, 0); PG8_LDB(B1, 0, 1); PG8_SCHED; PG8_LDA(At, 0, 0); PG8_STAGE(PG8_SA(1, 1), a1 + hstep, voffA);
            PG8_WAIT_V(8); PG8_WAIT_L(0); PG8_BAR; PG8_MMA(0, 0, At, B0); PG8_MMA(0, 1, At, B1); PG8_BAR; PG8_SCHED;
            PG8_LDA(At, 0, 1); PG8_STAGE(PG8_SB(0, 0), b2, voffB); PG8_STAGE(PG8_SB(0, 1), b2 + hstep, voffB); PG8_STAGE(PG8_SA(0, 0), a2, voffA);
            PG8_WAIT_V(8); PG8_WAIT_L(0); PG8_BAR; PG8_MMA(1, 0, At, B0); PG8_MMA(1, 1, At, B1); PG8_BAR; PG8_SCHED;
            PG8_LDB(B0, 1, 0); PG8_LDB(B1, 1, 1); PG8_SCHED; PG8_LDA(At, 1, 0); PG8_STAGE(PG8_SA(0, 1), a2 + hstep, voffA);
            PG8_WAIT_V(8); PG8_WAIT_L(0); PG8_BAR; PG8_MMA(0, 0, At, B0); PG8_MMA(0, 1, At, B1); PG8_BAR; PG8_SCHED;
            PG8_LDA(At, 1, 1); PG8_STAGE(PG8_SB(1, 0), b3, voffB); PG8_STAGE(PG8_SB(1, 1), b3 + hstep, voffB); PG8_STAGE(PG8_SA(1, 0), a3, voffA);
            PG8_WAIT_V(8); PG8_WAIT_L(0); PG8_BAR; PG8_MMA(1, 0, At, B0); PG8_MMA(1, 1, At, B1); PG8_BAR; PG8_SCHED;
            } else {
            PG8_LDB(B0, 0, 0); PG8_SCHED; PG8_LDA(At, 0, 0); PG8_STAGE(PG8_SA(1, 1), a1 + hstep, voffA);
            PG8_WAIT_L(8); PG8_BAR; PG8_WAIT_L(0); PG8_MMA(0, 0, At, B0); PG8_BAR; PG8_SCHED;
            PG8_LDB(B1, 0, 1); PG8_STAGE(PG8_SB(0, 0), b2, voffB);
            PG8_BAR; PG8_WAIT_L(0); PG8_MMA(0, 1, At, B1); PG8_BAR;
            PG8_LDA(At, 0, 1); PG8_STAGE(PG8_SA(0, 0), a2, voffA);
            PG8_BAR; PG8_WAIT_L(0); PG8_MMA(1, 0, At, B0); PG8_BAR; PG8_SCHED;
            PG8_STAGE(PG8_SB(0, 1), b2 + hstep, voffB);
            PG8_WAIT_V(6); PG8_BAR; PG8_MMA(1, 1, At, B1); PG8_BAR;
            PG8_LDB(B0, 1, 0); PG8_SCHED; PG8_LDA(At, 1, 0); PG8_STAGE(PG8_SA(0, 1), a2 + hstep, voffA);
            PG8_WAIT_L(8); PG8_BAR; PG8_WAIT_L(0); PG8_MMA(0, 0, At, B0); PG8_BAR; PG8_SCHED;
            PG8_LDB(B1, 1, 1); PG8_STAGE(PG8_SB(1, 0), b3, voffB);
            PG8_BAR; PG8_WAIT_L(0); PG8_MMA(0, 1, At, B1); PG8_BAR;
            PG8_LDA(At, 1, 1); PG8_STAGE(PG8_SA(1, 0), a3, voffA);
            PG8_BAR; PG8_WAIT_L(0); PG8_MMA(1, 0, At, B0); PG8_BAR; PG8_SCHED;
            PG8_STAGE(PG8_SB(1, 1), b3 + hstep, voffB);
            PG8_WAIT_V(6); PG8_BAR; PG8_MMA(1, 1, At, B1); PG8_BAR;
            }
        }
        if constexpr (ALIGN_EPI) { if (wr == 0) PG8_BAR; }
        if constexpr (!Epi::AFTER_DRAIN) { E(acc, cur, wr, wc, fr, fq); S.done(cur); }
        if (!has_next) break;
#pragma unroll
        for (int a = 0; a < 2; ++a)
#pragma unroll
            for (int b = 0; b < 2; ++b)
#pragma unroll
                for (int m = 0; m < 4; ++m)
#pragma unroll
                    for (int n = 0; n < 2; ++n) acc[a][b][m][n] = (f32x4){0.f, 0.f, 0.f, 0.f};
        cur = nxt; cA = nA; cB = nB; ++ui;
        if constexpr (ALIGN_EPI) { if (wr == 1) PG8_BAR; }
    }
    PG8_WAIT_V(0);
    if constexpr (!ALIGN_EPI) { if (wr == 0) PG8_BAR; }
    PG8_BAR;
    if constexpr (Epi::AFTER_DRAIN) { E.fused(acc, cur, wr, wc, fr, fq, lds, wid, lane); S.done(cur); }
#undef PG8_SA
#undef PG8_SB
#undef PG8_STAGE
#undef PG8_LDA
#undef PG8_LDB
#undef PG8_MMA
#undef PG8_WAIT_V
#undef PG8_WAIT_L
#undef PG8_BAR
#undef PG8_SCHED
}
}

#define GAS __attribute__((address_space(1)))
#define LAS __attribute__((address_space(3)))
typedef unsigned short bf16;
typedef unsigned v4u __attribute__((ext_vector_type(4)));
typedef float f32x4 __attribute__((ext_vector_type(4)));
typedef short bf16x8 __attribute__((ext_vector_type(8)));
typedef GAS unsigned gu32;
typedef GAS unsigned long long gu64;
#define RLX_AGENT __ATOMIC_RELAXED, __HIP_MEMORY_SCOPE_AGENT
#define LDS_WAIT() asm volatile("s_waitcnt lgkmcnt(0)" ::: "memory")
#define VM_WAIT() asm volatile("s_waitcnt vmcnt(0)" ::: "memory")
__device__ __forceinline__ unsigned long long rt() { return __builtin_amdgcn_s_memrealtime(); }
__device__ __forceinline__ unsigned f2bf(float f) { unsigned u = __builtin_bit_cast(unsigned, f); return (u + 0x7fffu + ((u >> 16) & 1u)) >> 16; }
__device__ __forceinline__ unsigned pk2(float lo, float hi) { return f2bf(lo) | (f2bf(hi) << 16); }
#define XB_TMO      128
#define XB_XCNT(j)  (256  + 64 * (j))
#define XB_XSUB(j)  (1280 + 64 * (j))
#define XB_XGEN(j)  (2304 + 64 * (j))
#define XB_TOP      3328
#define XB_TOPGEN   3392
#define XCD_BAR_WORDS 3456
#define XB_SPIN_CAP (1u << 18)

__device__ __forceinline__ unsigned xb_ld(unsigned* p)              { return __hip_atomic_load(p, __ATOMIC_RELAXED, __HIP_MEMORY_SCOPE_AGENT); }
__device__ __forceinline__ unsigned xb_add(unsigned* p, unsigned v) { return __hip_atomic_fetch_add(p, v, __ATOMIC_RELAXED, __HIP_MEMORY_SCOPE_AGENT); }
__device__ __forceinline__ unsigned xb_xcc_id() { return (unsigned)__builtin_amdgcn_s_getreg((3 << 11) | 20) & 0xFu; }
#define XB_SPIN(cond, bar) do { unsigned _sp = 0; while (cond) { __builtin_amdgcn_s_sleep(1); \
    if ((++_sp & 255u) == 0u) { if (xb_ld(&(bar)[XB_TMO])) break; if (_sp > XB_SPIN_CAP) { atomicAdd(&(bar)[XB_TMO], 1u); break; } } } } while (0)

struct XcdBarrier {
    unsigned* bar; unsigned x;
    volatile LAS unsigned* st;
};

__device__ __forceinline__ XcdBarrier xcd_barrier_post(unsigned* bar, volatile LAS unsigned* st) {
    XcdBarrier b; b.bar = bar; b.x = xb_xcc_id(); b.st = st;
    if (threadIdx.x == 0) (void)xb_add(&bar[XB_XCNT(b.x)], 1u);
    return b;
}
__device__ __forceinline__ void xcd_barrier_complete(unsigned* bar, unsigned x, unsigned& nloc, unsigned& nx) {
    const unsigned G = gridDim.x * gridDim.y * gridDim.z;
    unsigned sum, cnt, mine, sp = 0u;
    for (;;) {
        sum = 0u; cnt = 0u; mine = 0u;
#pragma unroll
        for (unsigned j = 0; j < 16; ++j) { const unsigned c = xb_ld(&bar[XB_XCNT(j)]); sum += c; cnt += (c > 0u) ? 1u : 0u; mine = (j == x) ? c : mine; }
        if (sum == G) break;
        __builtin_amdgcn_s_sleep(1);
        if ((++sp & 255u) == 0u) { if (xb_ld(&bar[XB_TMO])) break; if (sp > XB_SPIN_CAP) { atomicAdd(&bar[XB_TMO], 1u); break; } }
    }
    nloc = mine > 0u ? mine : 1u; nx = cnt > 0u ? cnt : 1u;
}

__device__ __forceinline__ void xcd_barrier(const XcdBarrier& b) {
    asm volatile("s_waitcnt vmcnt(0)" ::: "memory");
    __syncthreads();
    if (threadIdx.x == 0) {
        unsigned* bar = b.bar;
        __builtin_amdgcn_s_waitcnt(0);
        unsigned nloc = b.st[0], nx = b.st[1];
        if (nloc == 0u) { xcd_barrier_complete(bar, b.x, nloc, nx); b.st[0] = nloc; b.st[1] = nx; }
        const unsigned old = xb_add(&bar[XB_XSUB(b.x)], 1u);
        const unsigned gen = old / nloc;
        if (old + 1u == (gen + 1u) * nloc) {
            __builtin_amdgcn_fence(__ATOMIC_RELEASE, "agent");
            asm volatile("s_waitcnt vmcnt(0)" ::: "memory");
            const unsigned og = xb_add(&bar[XB_TOP], 1u);
            const unsigned tg = og / nx;
            if (og + 1u == (tg + 1u) * nx) xb_add(&bar[XB_TOPGEN], 1u);
            else XB_SPIN(xb_ld(&bar[XB_TOPGEN]) == tg, bar);
            __builtin_amdgcn_fence(__ATOMIC_ACQUIRE, "agent");
            xb_add(&bar[XB_XGEN(b.x)], 1u);
            asm volatile("s_waitcnt vmcnt(0)" ::: "memory");
        } else {
            XB_SPIN(xb_ld(&bar[XB_XGEN(b.x)]) == gen, bar);
            __builtin_amdgcn_fence(__ATOMIC_ACQUIRE, "agent");
            asm volatile("s_waitcnt vmcnt(0)" ::: "memory");
        }
    }
    __syncthreads();
}

constexpr size_t MiB = 1u << 20;
constexpr size_t WS_CTL = 0, CTL_ZERO_BYTES = 1 * MiB;
constexpr size_t WS_COS = 1 * MiB, WS_SIN = 5 * MiB;
constexpr size_t WS_MODS = 9 * MiB;
constexpr size_t WS_KVMOD = 9 * MiB + 256 * 1024;
constexpr size_t WS_SCQ = 9 * MiB + 320 * 1024, WS_SCK = WS_SCQ + 4096, WS_SCG = WS_SCQ + 8192;
constexpr size_t WS_BIAS = 9 * MiB + 384 * 1024;
constexpr size_t WS_WT_IN = 10 * MiB, WS_WT_OUT = 22 * MiB, WS_WT_UP = 26 * MiB, WS_WT_DOWN = 37 * MiB, WS_WT_KV = 43 * MiB;
constexpr size_t WS_KSH = 44 * MiB, WS_VSH = 52 * MiB;
constexpr size_t WS_R = 60 * MiB;
constexpr size_t WS_BIG = 188 * MiB;
constexpr size_t WS_END = 380 * MiB;
constexpr int CW_TMO = 0, CW_BAR = 4096;

constexpr int RING_OFF = 0, RING_BYTES = 131072;
constexpr int LDSCTL_OFF = 143360, MISC_OFF = LDSCTL_OFF + 320;
constexpr int LDS_BYTES = 147456;
constexpr int NWAVES = 8;

__constant__ unsigned char T5_BUCKET[128] = {0, 1, 2, 3, 4, 5, 6, 7, 8, 9, 10, 11, 12, 13, 14, 15, 16, 16, 16, 17, 17, 18, 18, 18, 19, 19, 19, 20, 20, 20, 20, 21, 21, 21, 21, 22, 22, 22, 22, 22, 23, 23, 23, 23, 23, 23, 24, 24, 24, 24, 24, 24, 25, 25, 25, 25, 25, 25, 25, 26, 26, 26, 26, 26, 26, 26, 26, 27, 27, 27, 27, 27, 27, 27, 27, 27, 27, 28, 28, 28, 28, 28, 28, 28, 28, 28, 28, 29, 29, 29, 29, 29, 29, 29, 29, 29, 29, 29, 29, 30, 30, 30, 30, 30, 30, 30, 30, 30, 30, 30, 30, 30, 30, 31, 31, 31, 31, 31, 31, 31, 31, 31, 31, 31, 31, 31, 31, 31};

struct Frame {
    LAS unsigned char* lds;
    volatile LAS unsigned* MISC;
    gu32* ctl;
    int tid, lane, wave, vcu, G, dry;
    unsigned char* ws;
    const float* __attribute__((address_space(4)))* in;
    float* out;
};
enum { I_X = 0, I_C, I_NORMG, I_ADAW, I_ADAB, I_RWIN, I_RWOUT, I_KVNG, I_KVADAW, I_KVADAB, I_KVW, I_SWQ, I_SWO, I_SINKS, I_RELB, I_WUP, I_CONVW, I_CONVB, I_WDOWN };

__device__ __forceinline__ void launder_ids(Frame& F) { int t = threadIdx.x; asm volatile("" : "+v"(t)); F.tid = t; F.lane = t & 63; F.wave = __builtin_amdgcn_readfirstlane(t >> 6); }
__device__ __forceinline__ float bf2f(bf16 h) { return __uint_as_float(((unsigned)h) << 16); }
__device__ __forceinline__ float wave_sum(float v) {
#pragma unroll
    for (int o = 1; o < 64; o <<= 1) v += __shfl_xor(v, o);
    return v;
}
__device__ __forceinline__ float wave_max(float v) {
#pragma unroll
    for (int o = 1; o < 64; o <<= 1) v = fmaxf(v, __shfl_xor(v, o));
    return v;
}
__device__ __forceinline__ float dot8(const v4u a, const v4u b) {
    float s = 0.f;
#pragma unroll
    for (int e = 0; e < 4; ++e) { s += __uint_as_float(a[e] << 16) * __uint_as_float(b[e] << 16); s += __uint_as_float(a[e] & 0xffff0000u) * __uint_as_float(b[e] & 0xffff0000u); }
    return s;
}
__device__ __forceinline__ float silu(float x) { return x * __builtin_amdgcn_rcpf(1.0f + __expf(-x)); }

__device__ __forceinline__ void phase_mods(Frame& F) {
    launder_ids(F);
    LAS float* cact = (LAS float*)(F.lds);
    LAS float* part = (LAS float*)(F.lds + 8192);
    for (int i = F.tid; i < 2 * D; i += 512) cact[i] = silu(F.in[I_C][i]);
    __syncthreads();
    const int item = F.vcu;
    const float* W = nullptr; const float* bias = nullptr; float* outp = nullptr; int N = 0, ostride = 0;
    if (item < 208) {
        const int col0 = item * 128;
        if (col0 < 4 * 6144) { const int l = col0 / 6144, cl = col0 % 6144; W = F.in[I_ADAW] + (size_t)l * D * 6144 + cl; N = 6144; bias = F.in[I_ADAB] + l * 6144 + cl; outp = (float*)(F.ws + WS_MODS) + l * 2 * 6144 + cl; ostride = 6144; }
        else { const int cl = col0 - 4 * 6144; W = F.in[I_KVADAW] + cl; N = 2048; bias = F.in[I_KVADAB] + cl; outp = (float*)(F.ws + WS_KVMOD) + cl; ostride = 2048; }
        const int cg = F.wave & 1, kq = F.wave >> 1, col = 64 * cg + F.lane, k0 = kq * 256;
        float a0 = 0.f, a1 = 0.f;
#pragma unroll 8
        for (int k = k0; k < k0 + 256; ++k) { const float w = W[(size_t)k * N + col]; a0 += w * cact[k]; a1 += w * cact[D + k]; }
        part[(F.wave * 2 + 0) * 64 + F.lane] = a0; part[(F.wave * 2 + 1) * 64 + F.lane] = a1;
    }
    __syncthreads();
    if (item < 208 && F.tid < 256) {
        const int b = F.tid >> 7, col = F.tid & 127, cg = col >> 6, ln = col & 63; float s = 0.f;
#pragma unroll
        for (int kq = 0; kq < 4; ++kq) s += part[(((kq << 1) | cg) * 2 + b) * 64 + ln];
        outp[b * ostride + col] = s + bias[col];
    }
    __syncthreads();
}
__device__ __forceinline__ void sincos_d(double a, double& s, double& c) {
    const double k = __builtin_rint(a * 0.6366197723675814);
    double r = __builtin_fma(-k, 1.5707963267948966, a); r = __builtin_fma(-k, 6.123233995736766e-17, r);
    const double r2 = r * r;
    double sp = 1.0 / 6227020800.0; sp = sp * r2 - 1.0 / 39916800.0; sp = sp * r2 + 1.0 / 362880.0; sp = sp * r2 - 1.0 / 5040.0; sp = sp * r2 + 1.0 / 120.0; sp = sp * r2 - 1.0 / 6.0; sp = r + r * r2 * sp;
    double cp = -1.0 / 87178291200.0; cp = cp * r2 + 1.0 / 479001600.0; cp = cp * r2 - 1.0 / 3628800.0; cp = cp * r2 + 1.0 / 40320.0; cp = cp * r2 - 1.0 / 720.0; cp = cp * r2 + 1.0 / 24.0; cp = cp * r2 - 0.5; cp = 1.0 + r2 * cp;
    const int q = ((int)k) & 3;
    s = (q == 0) ? sp : (q == 1) ? cp : (q == 2) ? -sp : -cp;
    c = (q == 0) ? cp : (q == 1) ? -sp : (q == 2) ? -cp : sp;
}
__device__ __forceinline__ void phase_tables(Frame& F) {
    launder_ids(F);
    float* cosT = (float*)(F.ws + WS_COS); float* sinT = (float*)(F.ws + WS_SIN);
    const int NT = F.G * 512;
    for (int idx = F.vcu * 512 + F.tid; idx < SEQ * 128; idx += NT) {
        const int pos = idx >> 7, i = idx & 127;
        double inv = 1.0, r = 0.930572040929699;
#pragma unroll
        for (int bit = 0; bit < 7; ++bit) { if ((i >> bit) & 1) inv *= r; r *= r; }
        double s, c; sincos_d((double)pos * inv, s, c);
        cosT[idx] = (float)c; sinT[idx] = (float)s;
    }
    if (F.vcu == F.G - 1) {
        float* scq = (float*)(F.ws + WS_SCQ); float* sck = (float*)(F.ws + WS_SCK); float* scg = (float*)(F.ws + WS_SCG); float* bias = (float*)(F.ws + WS_BIAS);
        { const int h = F.tid >> 7, p = F.tid & 127; double gam = 1.0 - 1.0 / (double)(32 << h), g = 1.0;
          for (int e = 0; e <= p; ++e) g *= gam;
          scq[F.tid] = (float)g; sck[F.tid] = (float)(0.0625 / g);
          if (p == 127) scg[h] = (float)g; }
        for (int idx = F.tid; idx < 16 * 128; idx += 512) { const int head = idx >> 7, dist = idx & 127; bias[idx] = F.in[I_RELB][(int)T5_BUCKET[dist] * 16 + head]; }
    }
}
__device__ __forceinline__ void transpose_item(const float* W, int K, int N, bf16* WT, LAS float* scr, int item, int lane, int mode) {
    const int nblk = N / 32, kb = item / nblk, nb = item % nblk, k0 = 64 * kb, n0 = 32 * nb;
    int r0 = n0; bool vperm = false; if (mode == 1) { r0 = n0 < 2048 ? n0 : (n0 < 4096 ? n0 + 2048 : n0 - 2048); vperm = (n0 >= 2048 && n0 < 4096); }
    if (mode == 2) r0 = n0 < 2816 ? (n0 >> 7) * 256 + (n0 & 127) : ((n0 - 2816) >> 7) * 256 + 128 + ((n0 - 2816) & 127);
#pragma unroll 8
    for (int i = 0; i < 32; ++i) { const int kk = 2 * i + (lane >> 5); scr[kk * 33 + (lane & 31)] = W[(size_t)(k0 + kk) * N + n0 + (lane & 31)]; }
    LDS_WAIT(); asm volatile("" ::: "memory");
    const int c = lane & 7;
#pragma unroll
    for (int j = 0; j < 4; ++j) { const int n = (lane >> 3) + 8 * j; const LAS float* s = scr + (8 * c) * 33 + n;
        v4u o; o.x = pk2(s[0 * 33], s[1 * 33]); o.y = pk2(s[2 * 33], s[3 * 33]); o.z = pk2(s[4 * 33], s[5 * 33]); o.w = pk2(s[6 * 33], s[7 * 33]);
        const int nr = vperm ? (16 * ((n >> 2) & 1) + 4 * (n >> 3) + (n & 3)) : n;
        *(GAS v4u*)(WT + (size_t)(r0 + nr) * K + k0 + 8 * c) = o; }
    LDS_WAIT(); asm volatile("" ::: "memory");
}
__device__ __forceinline__ void phase_weights(Frame& F, int layer) {
    launder_ids(F);
    LAS float* scr = (LAS float*)(F.lds + RING_OFF + F.wave * 16384);
    const int gw = F.vcu * NWAVES + F.wave, NGW = F.G * NWAVES;
    const bool ret = layer < 2; const int li = ret ? layer : layer - 2;
    const float* w0 = ret ? F.in[I_RWIN] + (size_t)li * D * RETN : F.in[I_SWQ] + (size_t)li * D * D;        const int K0 = D, N0 = ret ? RETN : D;
    const float* w1 = ret ? F.in[I_RWOUT] + (size_t)li * 2048 * D : F.in[I_SWO] + (size_t)li * D * D;       const int K1 = ret ? 2048 : D, N1 = D;
    const float* w2 = F.in[I_WUP] + (size_t)layer * D * FF2;   const int K2 = D, N2 = FF2;
    const float* w3 = F.in[I_WDOWN] + (size_t)layer * FF * D;  const int K3 = FF, N3 = D;
    const int i0 = (K0 / 64) * (N0 / 32), i1 = (K1 / 64) * (N1 / 32), i2 = (K2 / 64) * (N2 / 32), i3 = (K3 / 64) * (N3 / 32), i4 = (layer == 2) ? (D / 64) * (512 / 32) : 0;
    const int total = i0 + i1 + i2 + i3 + i4;
    for (int it = gw; it < total; it += NGW) {
        int r = it;
        if (r < i0) { transpose_item(w0, K0, N0, (bf16*)(F.ws + WS_WT_IN), scr, r, F.lane, ret ? 1 : 0); continue; } r -= i0;
        if (r < i1) { transpose_item(w1, K1, N1, (bf16*)(F.ws + WS_WT_OUT), scr, r, F.lane, 0); continue; } r -= i1;
        if (r < i2) { transpose_item(w2, K2, N2, (bf16*)(F.ws + WS_WT_UP), scr, r, F.lane, 2); continue; } r -= i2;
        if (r < i3) { transpose_item(w3, K3, N3, (bf16*)(F.ws + WS_WT_DOWN), scr, r, F.lane, 0); continue; } r -= i3;
        transpose_item(F.in[I_KVW], D, 512, (bf16*)(F.ws + WS_WT_KV), scr, r, F.lane, 0);
    }
}

struct RowPass {
    const float* xsrc; float* xdst; const bf16* y; const float* gpost; const float* gate; int gstride;
    bf16* h1; const float* g1; const float* sc1; const float* sh1; int st1;
    bf16* h2; const float* g2; const float* sc2; const float* sh2; int st2;
};
__device__ __forceinline__ void phase_rowpass(Frame& F, const RowPass& P) {
    launder_ids(F);
    const int gw = F.vcu * NWAVES + F.wave, NGW = F.G * NWAVES;
    const int c0 = 4 * F.lane;
    for (int bb = 0; bb < BATCH; ++bb) {
        f32x4 cA[4], cB1[4], cC1[4], cB2[4], cC2[4];
#pragma unroll
        for (int j = 0; j < 4; ++j) {
            const int c = c0 + 256 * j;
            if (P.y) { const f32x4 g = *(const f32x4*)(P.gpost + c), t = *(const f32x4*)(P.gate + bb * P.gstride + c); cA[j] = g * (t + 1.0f); } else cA[j] = (f32x4){0.f, 0.f, 0.f, 0.f};
            if (P.h1) { const f32x4 g = *(const f32x4*)(P.g1 + c), s = *(const f32x4*)(P.sc1 + bb * P.st1 + c); cB1[j] = g * (s + 1.0f); cC1[j] = *(const f32x4*)(P.sh1 + bb * P.st1 + c); } else { cB1[j] = (f32x4){0.f, 0.f, 0.f, 0.f}; cC1[j] = cB1[j]; }
            if (P.h2) { const f32x4 g = *(const f32x4*)(P.g2 + c), s = *(const f32x4*)(P.sc2 + bb * P.st2 + c); cB2[j] = g * (s + 1.0f); cC2[j] = *(const f32x4*)(P.sh2 + bb * P.st2 + c); } else { cB2[j] = (f32x4){0.f, 0.f, 0.f, 0.f}; cC2[j] = cB2[j]; }
        }
        for (int m = bb * SEQ + gw; m < (bb + 1) * SEQ; m += NGW) {
            f32x4 x[4];
#pragma unroll
            for (int j = 0; j < 4; ++j) x[j] = *(const f32x4*)(P.xsrc + (size_t)m * D + c0 + 256 * j);
            if (P.y) {
                f32x4 yv[4]; float ss = 0.f;
#pragma unroll
                for (int j = 0; j < 4; ++j) { const uint2 w = *(const uint2*)(P.y + (size_t)m * D + c0 + 256 * j);
                    yv[j] = (f32x4){__uint_as_float(w.x << 16), __uint_as_float(w.x & 0xffff0000u), __uint_as_float(w.y << 16), __uint_as_float(w.y & 0xffff0000u)};
                    ss += (yv[j][0] * yv[j][0] + yv[j][1] * yv[j][1]) + (yv[j][2] * yv[j][2] + yv[j][3] * yv[j][3]); }
                const float rstd = __builtin_amdgcn_rsqf(wave_sum(ss) * (1.0f / D) + NORM_EPS);
#pragma unroll
                for (int j = 0; j < 4; ++j) x[j] = x[j] + cA[j] * yv[j] * rstd;
            }
            if (P.xdst) {
#pragma unroll
                for (int j = 0; j < 4; ++j) *(f32x4*)(P.xdst + (size_t)m * D + c0 + 256 * j) = x[j];
            }
            if (P.h1 || P.h2) {
                float ss = 0.f;
#pragma unroll
                for (int j = 0; j < 4; ++j) ss += (x[j][0] * x[j][0] + x[j][1] * x[j][1]) + (x[j][2] * x[j][2] + x[j][3] * x[j][3]);
                const float rstd = __builtin_amdgcn_rsqf(wave_sum(ss) * (1.0f / D) + NORM_EPS);
                if (P.h1) {
#pragma unroll
                    for (int j = 0; j < 4; ++j) { const f32x4 h = x[j] * rstd * cB1[j] + cC1[j]; uint2 w; w.x = pk2(h[0], h[1]); w.y = pk2(h[2], h[3]); *(uint2*)(P.h1 + (size_t)m * D + c0 + 256 * j) = w; }
                }
                if (P.h2) {
#pragma unroll
                    for (int j = 0; j < 4; ++j) { const f32x4 h = x[j] * rstd * cB2[j] + cC2[j]; uint2 w; w.x = pk2(h[0], h[1]); w.y = pk2(h[2], h[3]); *(uint2*)(P.h2 + (size_t)m * D + c0 + 256 * j) = w; }
                }
            }
        }
    }
}

__device__ __forceinline__ void ffn_fixup(Frame& F, int layer, int pm) {
    launder_ids(F);
    const bf16* HALO = (const bf16*)(F.ws + WS_BIG + 96 * MiB); bf16* A = (bf16*)(F.ws + WS_BIG);
    const float* cw = F.in[I_CONVW] + (size_t)layer * 3 * FF2; const float* cb = F.in[I_CONVB] + (size_t)layer * FF2;
    for (int it = F.tid; it < 8 * 352; it += 512) {
        const int rr = it / 352, cgx = it - rr * 352, which = rr & 1, blk = 4 * pm + (rr >> 1), t = 64 * blk + which, ch0 = cgx * 8, col = (ch0 >> 7) * 256 + (ch0 & 127);
        const bool first = (blk & 127) == 0;
        const bf16* hb = HALO + ((size_t)blk * 4) * 5632 + col; const bf16* hp = HALO + ((size_t)(blk - 1) * 4) * 5632 + col;
        const v4u z = {0u, 0u, 0u, 0u};
        v4u g0, g1, g2, v0, v1, v2;
        if (which == 0) { g0 = *(const v4u*)(hb); v0 = *(const v4u*)(hb + 128);
                          g1 = first ? z : *(const v4u*)(hp + 3 * 5632); v1 = first ? z : *(const v4u*)(hp + 3 * 5632 + 128); g2 = first ? z : *(const v4u*)(hp + 2 * 5632); v2 = first ? z : *(const v4u*)(hp + 2 * 5632 + 128); }
        else { g0 = *(const v4u*)(hb + 5632); v0 = *(const v4u*)(hb + 5632 + 128); g1 = *(const v4u*)(hb); v1 = *(const v4u*)(hb + 128);
               g2 = first ? z : *(const v4u*)(hp + 3 * 5632); v2 = first ? z : *(const v4u*)(hp + 3 * 5632 + 128); }
        f32x4 wg[3][2], wv[3][2], bg[2], bv[2];
#pragma unroll
        for (int h = 0; h < 2; ++h) {
#pragma unroll
            for (int j = 0; j < 3; ++j) { wg[j][h] = *(const f32x4*)(cw + j * FF2 + ch0 + 4 * h); wv[j][h] = *(const f32x4*)(cw + j * FF2 + FF + ch0 + 4 * h); }
            bg[h] = *(const f32x4*)(cb + ch0 + 4 * h); bv[h] = *(const f32x4*)(cb + FF + ch0 + 4 * h);
        }
        v4u o;
#pragma unroll
        for (int e = 0; e < 4; ++e) {
            const int h = e >> 1, q = (e & 1) * 2;
            const float ga = bg[h][q] + wg[0][h][q] * __uint_as_float(g2[e] << 16) + wg[1][h][q] * __uint_as_float(g1[e] << 16) + wg[2][h][q] * __uint_as_float(g0[e] << 16);
            const float gb = bg[h][q + 1] + wg[0][h][q + 1] * __uint_as_float(g2[e] & 0xffff0000u) + wg[1][h][q + 1] * __uint_as_float(g1[e] & 0xffff0000u) + wg[2][h][q + 1] * __uint_as_float(g0[e] & 0xffff0000u);
            const float va = bv[h][q] + wv[0][h][q] * __uint_as_float(v2[e] << 16) + wv[1][h][q] * __uint_as_float(v1[e] << 16) + wv[2][h][q] * __uint_as_float(v0[e] << 16);
            const float vb = bv[h][q + 1] + wv[0][h][q + 1] * __uint_as_float(v2[e] & 0xffff0000u) + wv[1][h][q + 1] * __uint_as_float(v1[e] & 0xffff0000u) + wv[2][h][q + 1] * __uint_as_float(v0[e] & 0xffff0000u);
            o[e] = pk2(silu(ga) * va, silu(gb) * vb);
        }
        *(v4u*)(A + (size_t)t * FF + ch0) = o;
    }
    asm volatile("s_waitcnt vmcnt(0)" ::: "memory");
    __syncthreads();
}


typedef short v4i16_t __attribute__((ext_vector_type(4)));
typedef unsigned v2u __attribute__((ext_vector_type(2)));
#define MFMA16(a, b, c) __builtin_amdgcn_mfma_f32_16x16x32_bf16((a), (b), (c), 0, 0, 0)
__device__ __forceinline__ unsigned pk2h(float lo, float hi) { unsigned r; asm volatile("v_cvt_pk_bf16_f32 %0, %1, %2" : "=v"(r) : "v"(lo), "v"(hi)); return r; }

__device__ __forceinline__ void pass1_f(Frame& F) {
    launder_ids(F);
    const bf16* KF = (const bf16*)(F.ws + WS_BIG + 32 * MiB); const bf16* VF = (const bf16*)(F.ws + WS_BIG + 64 * MiB); bf16* RF = (bf16*)(F.ws + WS_R);
    const int bh = F.vcu >> 5, blk = F.vcu & 31, dkb = blk & 3, dvb = blk >> 2, b = bh >> 2, h = bh & 3;
    const float gch = ((const float*)(F.ws + WS_SCG))[h];
    constexpr int KTILE = 16384;
    const int tid = F.tid, lane = F.lane, g = lane >> 4, pair = F.wave & 1, nt = F.wave >> 1;
    const bf16* kg[2]; int kl[2]; bool ksw[2];
#pragma unroll
    for (int i = 0; i < 2; ++i) {
        const int u = tid + 512 * i, jt = u >> 7, ktl = (u >> 6) & 1, gg = (u >> 4) & 3, r = u & 15, j = 16 * jt + r, cc = 4 * ktl + gg;
        kg[i] = KF + ((size_t)((b * 64) * 4 + h) * 32768) + (size_t)((jt * 8 + 2 * dkb) * 512) + (u & 127) * 8;
        kl[i] = j * 128 + ((cc ^ (((j >> 3) & 1) << 2)) << 4); ksw[i] = (j >> 1) & 1;
    }
    const bf16* vgp = VF + ((size_t)(bh * 64) * 65536) + (size_t)(((4 * dvb + nt) * 4) * 512) + lane * 8;
    const int q4 = (lane >> 2) & 3, p4 = lane & 3;
    int aoff[2][2];
#pragma unroll
    for (int s = 0; s < 2; ++s)
#pragma unroll
        for (int t = 0; t < 2; ++t) { const int row = 8 * g + 4 * s + q4; const int unit = (pair * 8 + 2 * p4 + t) ^ ((row >> 1) & 1) ^ (((row >> 3) & 1) << 3); aoff[s][t] = row * 128 + unit * 8; }
    bf16* rdst = RF + ((size_t)(bh * 64) * 131072) + (size_t)(((4 * dvb + nt) * 8 + 2 * dkb + pair) * 512) + lane * 8;
    f32x4 acc0 = {0.f, 0.f, 0.f, 0.f}, acc1 = {0.f, 0.f, 0.f, 0.f};
    v4u k0[2], k1[2], k2[2], k3[2]; bf16x8 v0[4], v1[4], v2[4], v3[4];
#define P1_LOAD(n, rk, rv) do { _Pragma("unroll") for (int i_ = 0; i_ < 2; ++i_) rk[i_] = *(const v4u*)(kg[i_] + (size_t)(n) * 4 * 32768); \
                                 _Pragma("unroll") for (int i_ = 0; i_ < 4; ++i_) rv[i_] = *(const bf16x8*)(vgp + (size_t)(n) * 65536 + i_ * 512); } while (0)
#define P1_WRITE(rk, bufo) do { _Pragma("unroll") for (int i_ = 0; i_ < 2; ++i_) { v4u w_ = rk[i_]; if (ksw[i_]) w_ = (v4u){w_.z, w_.w, w_.x, w_.y}; *(LAS v4u*)(F.lds + (bufo) + kl[i_]) = w_; } } while (0)
#define P1_STEP(n, bufo, rkcur, rvcur, rknext) do { \
        { v4u w_; w_.x = pk2h(acc0[0], acc0[1]); w_.y = pk2h(acc0[2], acc0[3]); w_.z = pk2h(acc1[0], acc1[1]); w_.w = pk2h(acc1[2], acc1[3]); *(v4u*)(rdst + (size_t)(n) * 131072) = w_; } \
        if ((n) <= NCH - 2) { \
            _Pragma("unroll") for (int ks_ = 0; ks_ < 4; ++ks_) { \
                const LAS unsigned char* kb_ = F.lds + (bufo) + ks_ * 4096; \
                const v4i16_t x00 = __builtin_amdgcn_ds_read_tr16_b64_v4i16((LAS v4i16_t*)(kb_ + aoff[0][0])), x10 = __builtin_amdgcn_ds_read_tr16_b64_v4i16((LAS v4i16_t*)(kb_ + aoff[1][0])); \
                const v4i16_t x01 = __builtin_amdgcn_ds_read_tr16_b64_v4i16((LAS v4i16_t*)(kb_ + aoff[0][1])), x11 = __builtin_amdgcn_ds_read_tr16_b64_v4i16((LAS v4i16_t*)(kb_ + aoff[1][1])); \
                const bf16x8 a0_ = {x00[0], x00[1], x00[2], x00[3], x10[0], x10[1], x10[2], x10[3]}, a1_ = {x01[0], x01[1], x01[2], x01[3], x11[0], x11[1], x11[2], x11[3]}; \
                acc0 = MFMA16(a0_, rvcur[ks_], acc0); acc1 = MFMA16(a1_, rvcur[ks_], acc1); } \
            acc0 = acc0 * gch; acc1 = acc1 * gch; } \
        if ((n) + 4 <= NCH - 2) P1_LOAD((n) + 4, rkcur, rvcur); \
        if ((n) + 1 <= NCH - 2) P1_WRITE(rknext, ((bufo) == 0 ? KTILE : 0)); \
        __syncthreads(); } while (0)
    P1_LOAD(0, k0, v0); P1_LOAD(1, k1, v1); P1_LOAD(2, k2, v2); P1_LOAD(3, k3, v3);
    P1_WRITE(k0, 0);
    __syncthreads();
    for (int n = 0; n < NCH; n += 4) { P1_STEP(n, 0, k0, v0, k1); P1_STEP(n + 1, KTILE, k1, v1, k2); P1_STEP(n + 2, 0, k2, v2, k3); P1_STEP(n + 3, KTILE, k3, v3, k0); }
#undef P1_LOAD
#undef P1_WRITE
#undef P1_STEP
}

template <int DV> __device__ __forceinline__ void pass2_f(Frame& F) {
    launder_ids(F);
    const bf16* QF = (const bf16*)(F.ws + WS_BIG); const bf16* KF = (const bf16*)(F.ws + WS_BIG + 32 * MiB); const bf16* VF = (const bf16*)(F.ws + WS_BIG + 64 * MiB);
    const bf16* GF = (const bf16*)(F.ws + WS_BIG + 128 * MiB); const bf16* RF = (const bf16*)(F.ws + WS_R);
    bf16* O = (bf16*)(F.ws + WS_BIG + 128 * MiB);
    constexpr int PSTR = 272;
    LAS unsigned char* Pl = F.lds; LAS float* st = (LAS float*)(F.lds + 36864);
    const int lane = F.lane, c = lane & 15, g = lane >> 4, wr = F.wave >> 2, wc = F.wave & 3;
    for (int it = F.vcu; it < 512; it += F.G) {
        const int bh = (it & 255) >> 5, n = (it & 31) + 32 * (it >> 8), b = bh >> 2, h = bh & 3;
        const bf16* q = QF + ((size_t)((b * 64 + n) * 4 + h) * 32768) + lane * 8; const bf16* k = KF + ((size_t)((b * 64 + n) * 4 + h) * 32768) + lane * 8;
        const bf16* vt = VF + ((size_t)(bh * 64 + n) * 65536) + lane * 8; const bf16* rt = RF + ((size_t)(bh * 64 + n) * 131072) + lane * 8;
        const bf16* qb = q + (size_t)(4 * wr) * 8 * 512;
        if (!(wr == 0 && wc >= 2) && !(DV & 2)) {
            f32x4 s[2][4];
#pragma unroll
            for (int t = 0; t < 2; ++t)
#pragma unroll
                for (int mi = 0; mi < 4; ++mi) s[t][mi] = (f32x4){0.f, 0.f, 0.f, 0.f};
            const bf16* ka = k + (size_t)(2 * wc) * 8 * 512;
            bf16x8 a0[2], b0[4], a1[2], b1[4];
#define S_LOAD(ks_, a_, b_) do { _Pragma("unroll") for (int t = 0; t < 2; ++t) a_[t] = *(const bf16x8*)(ka + (size_t)(t * 8 + (ks_)) * 512); \
                                 _Pragma("unroll") for (int mi = 0; mi < 4; ++mi) b_[mi] = *(const bf16x8*)(qb + (size_t)(mi * 8 + (ks_)) * 512); } while (0)
#define S_MMA(a_, b_) do { _Pragma("unroll") for (int t = 0; t < 2; ++t) _Pragma("unroll") for (int mi = 0; mi < 4; ++mi) s[t][mi] = MFMA16(a_[t], b_[mi], s[t][mi]); } while (0)
            S_LOAD(0, a0, b0);
#pragma unroll
            for (int ks = 0; ks < 8; ks += 2) { S_LOAD(ks + 1, a1, b1); S_MMA(a0, b0); if (ks + 2 < 8) S_LOAD(ks + 2, a0, b0); S_MMA(a1, b1); }
#undef S_LOAD
#undef S_MMA
#pragma unroll
            for (int t = 0; t < 2; ++t)
#pragma unroll
                for (int mi = 0; mi < 4; ++mi) {
                    const int i = 64 * wr + 16 * mi + c, j0 = 32 * wc + 16 * t + 4 * g;
                    const float v0 = (j0 + 0 <= i) ? s[t][mi][0] : 0.f, v1 = (j0 + 1 <= i) ? s[t][mi][1] : 0.f, v2 = (j0 + 2 <= i) ? s[t][mi][2] : 0.f, v3 = (j0 + 3 <= i) ? s[t][mi][3] : 0.f;
                    v2u w; w.x = pk2h(v0, v1); w.y = pk2h(v2, v3);
                    *(LAS v2u*)(Pl + i * PSTR + j0 * 2) = w;
                }
        }
        const bf16* va = vt + (size_t)(8 * wc) * 4 * 512; const bf16* ra = rt + (size_t)(8 * wc) * 8 * 512;
        const LAS unsigned char* pb = Pl + (64 * wr + c) * PSTR + 16 * g;
        const int nks = (DV & 4) ? 0 : (wr == 0 ? 2 : 4), nst = nks + ((DV & 8) ? 0 : 8);
        bf16x8 fa[8], fb[8];
#define O_LOADA(st_, a_) do { if ((st_) < nks) { _Pragma("unroll") for (int ni = 0; ni < 8; ++ni) a_[ni] = *(const bf16x8*)(va + (size_t)(ni * 4 + (st_)) * 512); } \
                              else { _Pragma("unroll") for (int ni = 0; ni < 8; ++ni) a_[ni] = *(const bf16x8*)(ra + (size_t)(ni * 8 + ((st_) - nks)) * 512); } } while (0)
        O_LOADA(0, fa);
        __syncthreads();
        f32x4 acc[4][8];
#pragma unroll
        for (int mi = 0; mi < 4; ++mi)
#pragma unroll
            for (int ni = 0; ni < 8; ++ni) acc[mi][ni] = (f32x4){0.f, 0.f, 0.f, 0.f};
#define O_STEP(st_, a_) do { bf16x8 bq_[4]; \
            if ((st_) < nks) { _Pragma("unroll") for (int mi = 0; mi < 4; ++mi) bq_[mi] = *(const LAS bf16x8*)(pb + (16 * mi) * PSTR + 64 * (st_)); } \
            else { _Pragma("unroll") for (int mi = 0; mi < 4; ++mi) bq_[mi] = *(const bf16x8*)(qb + (size_t)(mi * 8 + ((st_) - nks)) * 512); } \
            _Pragma("unroll") for (int mi = 0; mi < 4; ++mi) _Pragma("unroll") for (int ni = 0; ni < 8; ++ni) acc[mi][ni] = MFMA16(a_[ni], bq_[mi], acc[mi][ni]); } while (0)
        for (int s2 = 0; s2 < nst; s2 += 2) {
            O_LOADA(s2 + 1, fb); O_STEP(s2, fa);
            if (s2 + 2 < nst) O_LOADA(s2 + 2, fa);
            O_STEP(s2 + 1, fb);
        }
#undef O_LOADA
#undef O_STEP
        v4u gv[4][4];
#pragma unroll
        for (int mi = 0; mi < 4; ++mi) { const bf16* gp = GF + (size_t)(b * SEQ + n * 128 + 16 * (4 * wr + mi) + 4 * wc) * 2048 + h * 512 + lane * 8;
#pragma unroll
            for (int p = 0; p < 4; ++p) gv[mi][p] = (DV & 16) ? (v4u){0u, 0u, 0u, 0u} : *(const v4u*)(gp + (size_t)p * 2048); }
#pragma unroll
        for (int mi = 0; mi < 4; ++mi) {
            float s = 0.f;
#pragma unroll
            for (int ni = 0; ni < 8; ++ni) s += (acc[mi][ni][0] + acc[mi][ni][1]) + (acc[mi][ni][2] + acc[mi][ni][3]);
            s += __shfl_xor(s, 16); s += __shfl_xor(s, 32);
            const float mw = s * (1.0f / 128.0f); float qq = 0.f;
#pragma unroll
            for (int ni = 0; ni < 8; ++ni) { const f32x4 d = acc[mi][ni] - mw; qq += (d[0] * d[0] + d[1] * d[1]) + (d[2] * d[2] + d[3] * d[3]); }
            qq += __shfl_xor(qq, 16); qq += __shfl_xor(qq, 32);
            if (g == 0) { const int i = 64 * wr + 16 * mi + c; st[(i * 4 + wc) * 2 + 0] = mw; st[(i * 4 + wc) * 2 + 1] = qq; }
        }
        asm volatile("s_waitcnt vmcnt(0)" ::: "memory");
        __syncthreads();
#pragma unroll
        for (int mi = 0; mi < 4; ++mi) {
            const int i = 64 * wr + 16 * mi + c;
            const f32x4 s01 = *(const LAS f32x4*)(st + i * 8), s23 = *(const LAS f32x4*)(st + i * 8 + 4);
            const float mean = ((s01[0] + s01[2]) + (s23[0] + s23[2])) * 0.25f;
            const float d0 = s01[0] - mean, d1 = s01[2] - mean, d2 = s23[0] - mean, d3 = s23[2] - mean;
            const float m2 = (s01[1] + s01[3]) + (s23[1] + s23[3]) + 128.0f * ((d0 * d0 + d1 * d1) + (d2 * d2 + d3 * d3));
            const float rstd = __builtin_amdgcn_rsqf(m2 * (1.0f / 512.0f) + NORM_EPS);
            bf16* op = O + (size_t)(b * SEQ + n * 128 + i) * 2048 + h * 512 + 128 * wc + 8 * g;
            if (DV & 1) op = (bf16*)(F.ws + WS_KSH) + (((size_t)(n * 128 + i) * 2048 + h * 512 + 128 * wc + 8 * g) & (4 * MiB - 1));
#pragma unroll
            for (int p = 0; p < 4; ++p) {
                const f32x4 o0 = (acc[mi][2 * p] - mean) * rstd, o1 = (acc[mi][2 * p + 1] - mean) * rstd; const v4u gq = gv[mi][p];
                v4u w; w.x = pk2h(__uint_as_float(gq.x << 16) * o0[0], __uint_as_float(gq.x & 0xffff0000u) * o0[1]); w.y = pk2h(__uint_as_float(gq.y << 16) * o0[2], __uint_as_float(gq.y & 0xffff0000u) * o0[3]);
                w.z = pk2h(__uint_as_float(gq.z << 16) * o1[0], __uint_as_float(gq.z & 0xffff0000u) * o1[1]); w.w = pk2h(__uint_as_float(gq.w << 16) * o1[2], __uint_as_float(gq.w & 0xffff0000u) * o1[3]);
                if (!(DV & 16)) *(v4u*)(op + 32 * p) = w;
            }
        }
    }
}

__device__ __forceinline__ void attn_fast2(Frame& F, int li) {
    launder_ids(F);
    bf16* Q = (bf16*)(F.ws + WS_BIG); const bf16* KS = (const bf16*)(F.ws + WS_KSH); const bf16* VTS = (const bf16*)(F.ws + WS_VSH);
    const float* sinks = F.in[I_SINKS] + li * 16;
    constexpr int KB = 32768, VSTR = 528, VB = 64 * VSTR, KOFF = 0, VOFF = 2 * KB, BOFF = VOFF + 2 * VB;
    static_assert(BOFF + 8192 <= LDSCTL_OFF, "attention LDS map");
    LAS float* bl = (LAS float*)(F.lds + BOFF);
    for (int i = F.tid; i < 16 * 128; i += 512) bl[i] = ((const float*)(F.ws + WS_BIAS))[i];
    const int tid = F.tid, lane = F.lane, c = lane & 15, g4 = lane >> 4, hg = F.wave >> 1, qh = F.wave & 1;
    v4u st[8];
#define AT_LOAD(it_) do { const int b_ = (it_) >> 8, n_ = ((it_) >> 2) & 63, hk_ = (it_) & 3; \
        _Pragma("unroll") for (int i_ = 0; i_ < 4; ++i_) { const int id_ = tid + 512 * i_; \
            { const int row_ = id_ >> 3, ch_ = id_ & 7; int kp_ = n_ * 128 - 128 + row_; kp_ = kp_ < 0 ? 0 : kp_; st[i_] = *(const v4u*)(KS + (size_t)(b_ * SEQ + kp_) * 256 + hk_ * 64 + ch_ * 8); } \
            { const int d_ = id_ >> 5, ch_ = id_ & 31; int kp_ = n_ * 128 - 128 + ch_ * 8; kp_ = kp_ < 0 ? 0 : kp_; st[4 + i_] = *(const v4u*)(VTS + (size_t)(b_ * 256 + hk_ * 64 + d_) * SEQ + kp_); } } } while (0)
#define AT_WRITE(buf_) do { _Pragma("unroll") for (int i_ = 0; i_ < 4; ++i_) { const int id_ = tid + 512 * i_; \
            { const int row_ = id_ >> 3, ch_ = id_ & 7; *(LAS v4u*)(F.lds + KOFF + (buf_) * KB + row_ * 128 + ((ch_ ^ (row_ & 7)) << 4)) = st[i_]; } \
            { const int d_ = id_ >> 5, ch_ = id_ & 31; *(LAS v4u*)(F.lds + VOFF + (buf_) * VB + d_ * VSTR + ch_ * 16) = st[4 + i_]; } } } while (0)
    int it = F.vcu, buf = 0;
    if (it < 512) { AT_LOAD(it); AT_WRITE(0); }
    __syncthreads();
    for (; it < 512; it += F.G, buf ^= 1) {
        const int itn = it + F.G;
        if (itn < 512) AT_LOAD(itn);
        const int b = it >> 8, n = (it >> 2) & 63, hk = it & 3, head = hk * 4 + hg;
        const float sink = sinks[head];
        const LAS float* bh_ = bl + head * 128;
        const LAS unsigned char* Kl = F.lds + KOFF + buf * KB; const LAS unsigned char* Vl = F.lds + VOFF + buf * VB;
        for (int mt = 0; mt < 4; ++mt) {
            const int i0 = 64 * qh + 16 * mt;
            const int kp0 = n * 128 - 128 + i0;
            bf16* qrow = Q + (size_t)(b * SEQ + n * 128 + i0 + c) * 1024 + head * 64;
            const bf16x8 q0 = *(const bf16x8*)(qrow + 8 * g4), q1 = *(const bf16x8*)(qrow + 32 + 8 * g4);
            f32x4 s[10];
#pragma unroll
            for (int kt = 0; kt < 9; ++kt) {
                const int r = i0 + 16 * kt + c;
                const bf16x8 k0 = *(const LAS bf16x8*)(Kl + r * 128 + ((g4 ^ (r & 7)) << 4)), k1 = *(const LAS bf16x8*)(Kl + r * 128 + (((4 + g4) ^ (r & 7)) << 4));
                f32x4 z = {0.f, 0.f, 0.f, 0.f};
                z = MFMA16(k0, q0, z); s[kt] = MFMA16(k1, q1, z);
            }
            float mx = sink;
#pragma unroll
            for (int kt = 0; kt < 9; ++kt)
#pragma unroll
                for (int e = 0; e < 4; ++e) {
                    const int jr = 16 * kt + 4 * g4 + e, dist = 128 + c - jr;
                    const bool ok = (dist >= 0) && (dist < 128) && (kp0 + jr >= 0);
                    const float v = ok ? s[kt][e] * 0.125f + bh_[dist & 127] : -INFINITY;
                    s[kt][e] = v; mx = fmaxf(mx, v);
                }
            mx = fmaxf(mx, __shfl_xor(mx, 16)); mx = fmaxf(mx, __shfl_xor(mx, 32));
            float sum = 0.f;
#pragma unroll
            for (int kt = 0; kt < 9; ++kt)
#pragma unroll
                for (int e = 0; e < 4; ++e) { const float p = __expf(s[kt][e] - mx); s[kt][e] = p; sum += p; }
            sum += __shfl_xor(sum, 16); sum += __shfl_xor(sum, 32);
            const float rden = 1.0f / (sum + __expf(sink - mx));
            s[9] = (f32x4){0.f, 0.f, 0.f, 0.f};
            f32x4 o[4];
#pragma unroll
            for (int dt = 0; dt < 4; ++dt) o[dt] = (f32x4){0.f, 0.f, 0.f, 0.f};
#pragma unroll
            for (int kk = 0; kk < 5; ++kk) {
                v4u pw; pw.x = pk2h(s[2 * kk][0] * rden, s[2 * kk][1] * rden); pw.y = pk2h(s[2 * kk][2] * rden, s[2 * kk][3] * rden);
                pw.z = pk2h(s[2 * kk + 1][0] * rden, s[2 * kk + 1][1] * rden); pw.w = pk2h(s[2 * kk + 1][2] * rden, s[2 * kk + 1][3] * rden);
                const bf16x8 pb = __builtin_bit_cast(bf16x8, pw);
                int ka = i0 + 32 * kk + 4 * g4, kb = ka + 16; ka = ka > 252 ? 252 : ka; kb = kb > 252 ? 252 : kb;
#pragma unroll
                for (int dt = 0; dt < 4; ++dt) {
                    const v2u va = *(const LAS v2u*)(Vl + (16 * dt + c) * VSTR + ka * 2), vb = *(const LAS v2u*)(Vl + (16 * dt + c) * VSTR + kb * 2);
                    const v4u vw = {va.x, va.y, vb.x, vb.y};
                    o[dt] = MFMA16(__builtin_bit_cast(bf16x8, vw), pb, o[dt]);
                }
            }
            bf16* orow = F.dry ? qrow + (size_t)16 * MiB : qrow;
#pragma unroll
            for (int dt = 0; dt < 4; ++dt) { v2u w; w.x = pk2h(o[dt][0], o[dt][1]); w.y = pk2h(o[dt][2], o[dt][3]); *(v2u*)(orow + 16 * dt + 4 * g4) = w; }
        }
        if (itn < 512) AT_WRITE(buf ^ 1);
        __syncthreads();
    }
#undef AT_LOAD
#undef AT_WRITE
}


constexpr int N_PHASES = 2 + 2 * 8 + 2 * 7;
struct Args { const float* in[19]; float* out; unsigned char* ws; int ph_lo, ph_hi, dry, pad; };
static_assert(sizeof(Args) == 19 * 8 + 8 + 8 + 16, "Args has no padding");

__global__ void __launch_bounds__(NWAVES * 64, 2) yoco_fwd(Args args) {
    extern __shared__ __attribute__((aligned(16))) unsigned char lds[];
    Frame F;
    F.lds = (LAS unsigned char*)lds;
    F.MISC = (volatile LAS unsigned*)(F.lds + MISC_OFF);
    F.G = gridDim.x; { const int bx = blockIdx.x; F.vcu = (F.G % 8 == 0) ? (bx % 8) * (F.G / 8) + bx / 8 : bx; }
    for (int u = threadIdx.x; u < (LDS_BYTES - LDSCTL_OFF) / 4; u += NWAVES * 64) ((LAS unsigned*)(F.lds + LDSCTL_OFF))[u] = 0u;
    __syncthreads();
    XcdBarrier bar; bar.bar = (unsigned*)(args.ws + WS_CTL) + CW_BAR; bar.x = 0; bar.st = nullptr;
    if (MK_N_LAUNCHES == 1) bar = xcd_barrier_post((unsigned*)(args.ws + WS_CTL) + CW_BAR, F.MISC + 8);

    int ph_first = args.ph_lo;
    if (ph_first == 0) {
        const Args __attribute__((address_space(4)))* ap = (const Args __attribute__((address_space(4)))*)__builtin_amdgcn_kernarg_segment_ptr();
        asm volatile("" : "+s"(ap));
        F.in = (const float* __attribute__((address_space(4)))*)&ap->in[0]; F.out = ap->out; F.ws = ap->ws; F.ctl = (gu32*)(F.ws + WS_CTL);
        phase_mods(F); phase_tables(F); phase_weights(F, 0);
        if (args.ph_hi > 1) { if (MK_N_LAUNCHES == 1) xcd_barrier(bar); }
        ph_first = 1;
    }
    for (int ph = ph_first; ph < args.ph_hi; ++ph) {
        const Args __attribute__((address_space(4)))* ap = (const Args __attribute__((address_space(4)))*)__builtin_amdgcn_kernarg_segment_ptr();
        asm volatile("" : "+s"(ap));
        F.in = (const float* __attribute__((address_space(4)))*)&ap->in[0]; F.out = ap->out; F.ws = ap->ws; F.ctl = (gu32*)(F.ws + WS_CTL); F.dry = ap->dry;
        unsigned char* ws = F.ws;
        bf16* const H = (bf16*)(ws + WS_R); bf16* const HKV = (bf16*)(ws + WS_R + 32 * MiB); bf16* const Y2 = (bf16*)(ws + WS_R + 64 * MiB);
        bf16* const BIG = (bf16*)(ws + WS_BIG);
        const float* const MODS = (const float*)(ws + WS_MODS); const float* const KVMOD = (const float*)(ws + WS_KVMOD);
        int layer = -1, sub = -1;
        if (ph >= 2) { int p = ph - 2; if (p < 16) { layer = p / 8; sub = p % 8; } else { p -= 16; layer = 2 + p / 7; sub = 10 + p % 7; } }
        const bool ret = layer >= 0 && layer < 2;
        const bool is_rp_start = (ph == 1);
        const bool is_rp_mid = (sub == 4) || (sub == 13);
        const bool is_rp_end = (sub == 7) || (sub == 16);
        const bool is_gemm_out = (sub == 3) || (sub == 12);
        const bool is_gemm_up = (sub == 5) || (sub == 14);
        const bool is_gemm_down = (sub == 6) || (sub == 15);
        const bool is_gemm_q = (sub == 10);

        if (is_rp_start || is_rp_mid || is_rp_end) {
            RowPass P{};
            if (is_rp_start) {
                P.xsrc = F.in[I_X]; P.xdst = nullptr; P.y = nullptr;
                P.h1 = H; P.g1 = F.in[I_NORMG] + (0 * 4 + 0) * D; P.sc1 = MODS + 1 * D; P.sh1 = MODS + 0 * D; P.st1 = 6144;
            } else if (is_rp_mid) {
                P.xsrc = (layer == 0) ? F.in[I_X] : F.out; P.xdst = F.out;
                P.y = ret ? BIG : BIG + (size_t)16 * MiB;
                P.gpost = F.in[I_NORMG] + (layer * 4 + 1) * D; P.gate = MODS + (size_t)layer * 2 * 6144 + 2 * D; P.gstride = 6144;
                P.h1 = H; P.g1 = F.in[I_NORMG] + (layer * 4 + 2) * D; P.sc1 = MODS + (size_t)layer * 2 * 6144 + 4 * D; P.sh1 = MODS + (size_t)layer * 2 * 6144 + 3 * D; P.st1 = 6144;
            } else {
                P.xsrc = F.out; P.xdst = F.out; P.y = Y2;
                P.gpost = F.in[I_NORMG] + (layer * 4 + 3) * D; P.gate = MODS + (size_t)layer * 2 * 6144 + 5 * D; P.gstride = 6144;
                if (layer < 3) { P.h1 = H; P.g1 = F.in[I_NORMG] + ((layer + 1) * 4 + 0) * D; P.sc1 = MODS + (size_t)(layer + 1) * 2 * 6144 + 1 * D; P.sh1 = MODS + (size_t)(layer + 1) * 2 * 6144; P.st1 = 6144; }
                if (layer == 1) { P.h2 = HKV; P.g2 = F.in[I_KVNG]; P.sc2 = KVMOD + D; P.sh2 = KVMOD; P.st2 = 2048; }
            }
            if (F.dry) P.xdst = nullptr;
            phase_rowpass(F, P);
            if (is_rp_end && layer < 3) phase_weights(F, layer + 1);
        }

        if (sub == 0) {
            pg8::Gemm g{H, (const bf16*)(ws + WS_WT_IN), M, 4096, D}; pg8::StaticOrder S; S.init(M, 4096, F.G, (int)blockIdx.x);
            pg8::EpiRetQKG E{BIG, BIG + (size_t)16 * MiB, BIG + (size_t)64 * MiB, (const float*)(ws + WS_COS), (const float*)(ws + WS_SIN), (const float*)(ws + WS_SCQ), (const float*)(ws + WS_SCK)};
            pg8::gemm_phase<pg8::EpiRetQKG, pg8::StaticOrder, true, true>(F.lds + RING_OFF, g, S, E);
        }
        if (sub == 0 || (sub == 10 && layer == 2)) {
            pg8::Gemm g{}; pg8::EpiVT E{}; int cid = (int)blockIdx.x;
            if (sub == 0) { g = pg8::Gemm{(const bf16*)(ws + WS_WT_IN) + (size_t)4096 * D, H, 2048, M, D}; E.VT = BIG + (size_t)32 * MiB; E.mode = 0; }
            else { g = pg8::Gemm{(const bf16*)(ws + WS_WT_KV) + (size_t)256 * D, HKV, 256, M, D}; E.VT = (bf16*)(ws + WS_VSH); E.mode = 1; cid = (cid + F.G / 2) % F.G; }
            pg8::StaticOrder S; S.init(g.M, g.N, F.G, cid);
            pg8::gemm_phase<pg8::EpiVT, pg8::StaticOrder, true, true>(F.lds + RING_OFF, g, S, E);
        }
        if (sub == 1) { pass1_f(F); }
#if PROBE_MASK != 0
        if (sub == 2) { if (F.dry) pass2_f<DRY_VARIANT>(F); else pass2_f<0>(F); }
#else
        if (sub == 2) { pass2_f<0>(F); }
#endif
        if (sub == 11) { attn_fast2(F, layer - 2); }

        if (is_gemm_up) {
            pg8::Gemm g{H, (const bf16*)(ws + WS_WT_UP), M, FF2, D}; pg8::StaticOrder S; S.init(M, FF2, F.G, (int)blockIdx.x);
            pg8::EpiUpConv E{BIG, BIG + (size_t)48 * MiB, F.in[I_CONVW] + (size_t)layer * 3 * FF2, F.in[I_CONVB] + (size_t)layer * FF2};
            pg8::gemm_phase<pg8::EpiUpConv, pg8::StaticOrder, true, true>(F.lds + RING_OFF, g, S, E);
        }
        if (is_gemm_down) { pg8::StaticOrder S; S.init(M, D, F.G, (int)blockIdx.x); pg8::Unit u0; if (S.next(0, u0)) ffn_fixup(F, layer, u0.pm); }
        if (is_gemm_out || is_gemm_down || is_gemm_q) {
            const int ng = (is_gemm_q && layer == 2) ? 2 : 1;
            for (int gi = 0; gi < ng; ++gi) {
                pg8::Gemm g{}; pg8::EpiBf16S E{};
                E.scale = 1.0f; E.split_cols = 0; E.split_stride = 0;
                if (is_gemm_q) {
                    if (gi == 0) { g = pg8::Gemm{H, (const bf16*)(ws + WS_WT_IN), M, D, D}; E.O = BIG; E.ldc = D; }
                    else { g = pg8::Gemm{HKV, (const bf16*)(ws + WS_WT_KV), M, 256, D}; E.O = (bf16*)(ws + WS_KSH); E.ldc = 256; }
                } else if (is_gemm_out) {
                    if (ret) { g = pg8::Gemm{BIG + (size_t)64 * MiB, (const bf16*)(ws + WS_WT_OUT), M, D, 2048}; E.O = BIG; E.ldc = D; }
                    else { g = pg8::Gemm{BIG, (const bf16*)(ws + WS_WT_OUT), M, D, D}; E.O = BIG + (size_t)16 * MiB; E.ldc = D; }
                } else {
                    g = pg8::Gemm{BIG, (const bf16*)(ws + WS_WT_DOWN), M, D, FF}; E.O = Y2; E.ldc = D;
                }
                pg8::StaticOrder S; S.init(g.M, g.N, F.G, (int)blockIdx.x);
                pg8::gemm_phase<pg8::EpiBf16S, pg8::StaticOrder, true, true>(F.lds + RING_OFF, g, S, E);
            }
        }

        if (ph + 1 < args.ph_hi) { if (MK_N_LAUNCHES == 1) xcd_barrier(bar); }
    }
}

extern "C" void kernel_launch(void* const* d_in, const int* in_sizes, int n_in, void* d_out, int out_size, void* d_ws, size_t ws_size, hipStream_t stream) {
    static int grid = 0;
    if (grid == 0) {
        if (n_in != 19 || in_sizes[0] != M * D || out_size != M * D || ws_size < WS_END) { fprintf(stderr, "kernel_launch: unexpected problem (n_in %d, in0 %d, out %d, ws %zu); nothing launched\n", n_in, n_in > 0 ? in_sizes[0] : -1, out_size, ws_size); grid = -1; return; }
        int dev = 0, cus = 0;
        if (hipGetDevice(&dev) != hipSuccess || hipDeviceGetAttribute(&cus, hipDeviceAttributeMultiprocessorCount, dev) != hipSuccess) { grid = -1; return; }
        if (hipFuncSetAttribute((const void*)yoco_fwd, hipFuncAttributeMaxDynamicSharedMemorySize, LDS_BYTES) != hipSuccess) { fprintf(stderr, "kernel_launch: hipFuncSetAttribute failed\n"); grid = -1; return; }
        int per_cu = 0;
        if (hipOccupancyMaxActiveBlocksPerMultiprocessor(&per_cu, (const void*)yoco_fwd, NWAVES * 64, LDS_BYTES) != hipSuccess || per_cu < 1) fprintf(stderr, "kernel_launch: note: occupancy query reports %d workgroups per CU\n", per_cu);
        (void)hipGetLastError();
        if (cus != 256) { fprintf(stderr, "kernel_launch: this kernel is laid out for 256 CUs, found %d; nothing launched\n", cus); grid = -1; return; }
        grid = cus;
    }
    if (grid < 0) return;
    if (hipMemsetAsync((char*)d_ws + WS_CTL, 0, CTL_ZERO_BYTES, stream) != hipSuccess) return;
    Args a{};
    for (int i = 0; i < 19; ++i) a.in[i] = (const float*)d_in[i];
    a.out = (float*)d_out; a.ws = (unsigned char*)d_ws;
    if (MK_N_LAUNCHES == 1) {
        a.ph_lo = 0; a.ph_hi = N_PHASES;
        hipLaunchKernelGGL(yoco_fwd, dim3(grid), dim3(NWAVES * 64), LDS_BYTES, stream, a);
    } else {
        for (int ph = 0; ph < N_PHASES; ++ph) {
            int sub = -1; if (ph >= 2) { int p = ph - 2; if (p < 16) sub = p % 8; else sub = 10 + (p - 16) % 7; }
            int kind = 0;
            if (ph == 0) kind = 8; else if (ph == 1) kind = 16; else if (sub == 0) kind = 256; else if (sub == 3) kind = 512; else if (sub == 5 || sub == 14) kind = 1024; else if (sub == 6 || sub == 15) kind = 2048;
            else if (sub == 10 || sub == 12) kind = 4096; else if (sub == 1) kind = 4;
            else if (sub == 2) kind = 32; else if (sub == 11) kind = 64; else if (sub == 4 || sub == 13) kind = 128; else if (sub == 7 || sub == 16) kind = 8192;
            const int nrep = (PROBE_MASK & kind) ? 2 : 1; const bool inplace = (kind == 32 || kind == 64 || kind == 128 || kind == 8192);
            for (int rep = 0; rep < nrep; ++rep) { a.ph_lo = ph; a.ph_hi = ph + 1; a.dry = (inplace && nrep == 2 && rep == 0) ? DRY_VARIANT : 0; hipLaunchKernelGGL(yoco_fwd, dim3(grid), dim3(NWAVES * 64), LDS_BYTES, stream, a); }
        }
    }
}
```
